# Optimizing an MI355X kernel written in HIP

```python
import math
import jax, jax.numpy as jnp
from jax import lax
import numpy as np

D_MODEL = 1024
BATCH = 16
SEQ = 4096
DEPTH = 4

N_MIXERS = 2
N_ATTN_LAYERS = (DEPTH + 1) // 2
N_HGRN_LAYERS = DEPTH // 2

ATTN_HEADS = 8
ATTN_HEAD_DIM = 64
ATTN_V_DIM = 2 * ATTN_HEAD_DIM
ROPE_THETA = 10000.0
Q_BLOCK = 128
SUBLN_EPS = 1e-5
LAMBDA_STD = 0.1

HG_HEADS = 8
HG_KEY_DIM = D_MODEL // HG_HEADS
HG_VAL_DIM = D_MODEL // HG_HEADS
CHUNK = 16
GNORM_EPS = 1e-6

FFN_HIDDEN = ((8 * D_MODEL // 3 + 255) // 256) * 256
NORM_EPS = 1e-6
MAX_POS_OFFSET = 1024

kernel_name = "interleaved_diffattn_hgrn2_swiglu"

F32 = jnp.float32


def rms_norm(x, w, eps=NORM_EPS):
    xf = x.astype(F32)
    y = xf * lax.rsqrt(jnp.mean(xf * xf, axis=-1, keepdims=True) + eps)
    return (y * w.astype(F32)).astype(x.dtype)


def rope_tables(positions):
    inv_freq = 1.0 / (ROPE_THETA ** (jnp.arange(0, ATTN_HEAD_DIM, 2, dtype=F32) / ATTN_HEAD_DIM))
    ang = positions.astype(F32)[..., None] * inv_freq
    return jnp.cos(ang), jnp.sin(ang)


def apply_rope(t, cos, sin):
    tf = t.astype(F32)
    t1, t2 = jnp.split(tf, 2, axis=-1)
    c = cos[:, :, None, None, :]
    s = sin[:, :, None, None, :]
    return jnp.concatenate([t1 * c - t2 * s, t2 * c + t1 * s], axis=-1).astype(t.dtype)


def lambda_init_fn(layer_idx):
    return 0.8 - 0.6 * math.exp(-0.3 * layer_idx)


def diff_attention(h, cos, sin, w_in, w_out, lq1, lk1, lq2, lk2, subln_w, lambda_init):
    B, S, _ = h.shape
    qkv = h @ w_in
    q, k, v = jnp.split(qkv, [D_MODEL, 2 * D_MODEL], axis=-1)
    q = apply_rope(q.reshape(B, S, ATTN_HEADS, 2, ATTN_HEAD_DIM), cos, sin)
    k = apply_rope(k.reshape(B, S, ATTN_HEADS, 2, ATTN_HEAD_DIM), cos, sin)
    v = v.reshape(B, S, ATTN_HEADS, ATTN_V_DIM)
    lam = (jnp.exp(jnp.sum(lq1.astype(F32) * lk1.astype(F32)))
           - jnp.exp(jnp.sum(lq2.astype(F32) * lk2.astype(F32))) + lambda_init)
    scale = ATTN_HEAD_DIM ** -0.5
    n_blk = S // Q_BLOCK
    q_blocks = q.reshape(B, n_blk, Q_BLOCK, ATTN_HEADS, 2, ATTN_HEAD_DIM).transpose(1, 0, 2, 3, 4, 5)
    k_idx = jnp.arange(S)

    def block(args):
        qb, blk = args
        s = jnp.einsum('bqhcd,bkhcd->bhcqk', qb, k).astype(F32) * scale
        q_idx = blk * Q_BLOCK + jnp.arange(Q_BLOCK)
        causal = k_idx[None, :] <= q_idx[:, None]
        s = jnp.where(causal, s, jnp.finfo(F32).min)
        p = jax.nn.softmax(s, axis=-1)
        a = p[:, :, 0] - lam * p[:, :, 1]
        return jnp.einsum('bhqk,bkhe->bqhe', a.astype(v.dtype), v)

    o = lax.map(block, (q_blocks, jnp.arange(n_blk)))
    o = o.transpose(1, 0, 2, 3, 4).reshape(B, S, ATTN_HEADS, ATTN_V_DIM)
    o = rms_norm(o, subln_w, SUBLN_EPS).astype(F32) * (1.0 - lambda_init)
    return o.reshape(B, S, D_MODEL).astype(h.dtype) @ w_out


def hgrn2_mixer(h, w_in, w_out, gnorm_w, lb):
    B, S, _ = h.shape
    n_c = S // CHUNK
    q, fz, i, g = jnp.split(h @ w_in, 4, axis=-1)
    f = lb.astype(F32) + (1.0 - lb.astype(F32)) * jax.nn.sigmoid(fz.astype(F32))
    k = 1.0 - f
    logf = jnp.log(f)

    def to_chunks(t):
        return t.reshape(B, n_c, CHUNK, HG_HEADS, -1).transpose(0, 3, 1, 2, 4)

    qc = to_chunks(jax.nn.silu(q.astype(F32)))
    kc = to_chunks(k)
    vc = to_chunks(i.astype(F32))
    bc = jnp.cumsum(to_chunks(logf), axis=3)

    qd = qc * jnp.exp(bc)
    kd = kc * jnp.exp(-bc)
    causal = jnp.tril(jnp.ones((CHUNK, CHUNK), dtype=bool))
    A = jnp.where(causal, jnp.einsum('bhncK,bhnjK->bhncj', qd, kd), 0.0)
    o_intra = jnp.einsum('bhncj,bhnjv->bhncv', A, vc)

    b_last = bc[:, :, :, -1:, :]
    k_to_end = kc * jnp.exp(b_last - bc)
    chunk_decay = jnp.exp(b_last[:, :, :, 0, :])

    def step(state, xs):
        qd_n, kend_n, v_n, dec_n = xs
        o_n = jnp.einsum('bhcK,bhKv->bhcv', qd_n, state)
        state = dec_n[..., None] * state + jnp.einsum('bhcK,bhcv->bhKv', kend_n, v_n)
        return state, o_n

    xs = (jnp.moveaxis(qd, 2, 0), jnp.moveaxis(k_to_end, 2, 0),
          jnp.moveaxis(vc, 2, 0), jnp.moveaxis(chunk_decay, 2, 0))
    state0 = jnp.zeros((B, HG_HEADS, HG_KEY_DIM, HG_VAL_DIM), F32)
    _, o_inter = lax.scan(step, state0, xs)
    o = o_intra + jnp.moveaxis(o_inter, 0, 2)
    o = o.transpose(0, 2, 3, 1, 4).reshape(B, S, HG_HEADS, HG_VAL_DIM)
    o = rms_norm(o, gnorm_w, GNORM_EPS) * jax.nn.silu(g.astype(F32)).reshape(B, S, HG_HEADS, HG_VAL_DIM)
    return o.reshape(B, S, D_MODEL).astype(h.dtype) @ w_out


def swiglu(h, w_in, w_out):
    gate, up = jnp.split(h @ w_in, 2, axis=-1)
    return (jax.nn.silu(gate) * up) @ w_out


def setup_inputs(seed: int = 0) -> dict:
    key = jax.random.key(seed)
    ks = jax.random.split(key, 20)
    D = D_MODEL
    nrm = lambda k, shape, s: jax.random.normal(k, shape, F32) * s
    x = jax.random.normal(ks[0], (BATCH, SEQ, D), F32)
    start = jax.random.randint(ks[1], (BATCH, 1), 0, MAX_POS_OFFSET, dtype=jnp.int32)
    positions = (start + jnp.arange(SEQ, dtype=jnp.int32)[None, :]).astype(jnp.int32)
    return {
        "x": x,
        "positions": positions,
        "norm_mix_w": 1.0 + nrm(ks[2], (DEPTH, D), 0.02),
        "norm_ffn_w": 1.0 + nrm(ks[3], (DEPTH, D), 0.02),
        "final_norm_w": 1.0 + nrm(ks[4], (D,), 0.02),
        "attn_w_in": nrm(ks[5], (N_ATTN_LAYERS, D, 3 * D), D ** -0.5),
        "attn_w_out": nrm(ks[6], (N_ATTN_LAYERS, D, D), D ** -0.5),
        "attn_lambda_q1": nrm(ks[7], (N_ATTN_LAYERS, ATTN_HEAD_DIM), LAMBDA_STD),
        "attn_lambda_k1": nrm(ks[8], (N_ATTN_LAYERS, ATTN_HEAD_DIM), LAMBDA_STD),
        "attn_lambda_q2": nrm(ks[9], (N_ATTN_LAYERS, ATTN_HEAD_DIM), LAMBDA_STD),
        "attn_lambda_k2": nrm(ks[10], (N_ATTN_LAYERS, ATTN_HEAD_DIM), LAMBDA_STD),
        "attn_subln_w": 1.0 + nrm(ks[11], (N_ATTN_LAYERS, ATTN_V_DIM), 0.02),
        "hgrn_w_in": nrm(ks[12], (N_HGRN_LAYERS, D, 4 * D), D ** -0.5),
        "hgrn_w_out": nrm(ks[13], (N_HGRN_LAYERS, D, D), D ** -0.5),
        "hgrn_gnorm_w": 1.0 + nrm(ks[14], (N_HGRN_LAYERS, HG_VAL_DIM), 0.02),
        "hgrn_lb_param": nrm(ks[15], (DEPTH, D), 0.1),
        "ffn_w_in": nrm(ks[16], (DEPTH, D, 2 * FFN_HIDDEN), D ** -0.5),
        "ffn_w_out": nrm(ks[17], (DEPTH, FFN_HIDDEN, D), FFN_HIDDEN ** -0.5),
    }


def reference(x, positions, norm_mix_w, norm_ffn_w, final_norm_w,
              attn_w_in, attn_w_out, attn_lambda_q1, attn_lambda_k1, attn_lambda_q2, attn_lambda_k2,
              attn_subln_w, hgrn_w_in, hgrn_w_out, hgrn_gnorm_w, hgrn_lb_param,
              ffn_w_in, ffn_w_out):
    cos, sin = rope_tables(positions)
    lbs = jnp.cumsum(jax.nn.softmax(hgrn_lb_param.astype(F32), axis=0), axis=0)
    lbs = lbs - lbs[0:1]
    for i in range(DEPTH):
        h = rms_norm(x, norm_mix_w[i])
        j = i // N_MIXERS
        if i % N_MIXERS == 0:
            y = diff_attention(h, cos, sin, attn_w_in[j], attn_w_out[j],
                               attn_lambda_q1[j], attn_lambda_k1[j], attn_lambda_q2[j], attn_lambda_k2[j],
                               attn_subln_w[j], lambda_init_fn(i))
        else:
            y = hgrn2_mixer(h, hgrn_w_in[j], hgrn_w_out[j], hgrn_gnorm_w[j], lbs[i])
        x = x + y.astype(x.dtype)
        x = x + swiglu(rms_norm(x, norm_ffn_w[i]), ffn_w_in[i], ffn_w_out[i]).astype(x.dtype)
    return rms_norm(x, final_norm_w)
```

```cpp
#include <hip/hip_runtime.h>
#include <hip/hip_bf16.h>
#include <hip/hip_cooperative_groups.h>
#include <cstdio>
#include <cstdint>
namespace cg = cooperative_groups;
#ifndef MK_ATTN128
#define MK_ATTN128 1
#endif
#ifndef MK_FUSE_COMBINE
#define MK_FUSE_COMBINE 1
#endif
#ifndef MK_ATTN_X2
#define MK_ATTN_X2 1
#endif
#ifndef MK_MULTI
#define MK_MULTI 0
#endif
__device__ __forceinline__ int mk_tid() { int t = threadIdx.x; asm volatile("" : "+v"(t)); return t; }
namespace pg8 {
#define PG8_LAS __attribute__((address_space(3)))
typedef unsigned short bf16_t;
typedef short bf16x8 __attribute__((ext_vector_type(8)));
typedef float f32x4 __attribute__((ext_vector_type(4)));
typedef unsigned u32x4 __attribute__((ext_vector_type(4)));
constexpr int BM = 256, BK = 64, HALF = 128, HTB = HALF * BK * 2  , STAGE_BYTES = 8 * HTB, NXCD = 8, WGM = 8;

__host__ __device__ __forceinline__ int lds_byte(int r, int c) { const int st = (r >> 4) * 2 + (c >> 5), rr = r & 15, cc = c & 31, ob = rr * 64 + cc * 2; return st * 1024 + (ob ^ (((ob >> 9) & 1) << 5)); }
__host__ __device__ __forceinline__ void stage_rc(int b, int& R, int& C) { const int st = b / 1024, sb = b % 1024, swz = sb ^ (((sb >> 9) & 1) << 5); R = (st >> 1) * 16 + swz / 64; C = (st & 1) * 32 + (swz % 64) / 2; }
__host__ __device__ __forceinline__ int perm32(int rho) { const int n = rho >> 4, i = rho & 15; return 8 * (i >> 2) + 4 * n + (i & 3); }

struct Unit { int pm, pn; };
struct Gemm { const bf16_t* A; const bf16_t* Bt; int M, N, K; };

struct StaticOrder {
    int nM, nN, nwg, G, c;
    __host__ __device__ void init(int M, int N, int G_, int c_) { nM = M / BM; nN = N / BM; nwg = nM * nN; G = G_; c = c_; }
    __host__ __device__ bool next(int i, Unit& u) const {
        const long L = (long)i * G + c; if (L >= nwg) return false;
        int wgid = (int)L; { const int q = nwg / NXCD, r = nwg % NXCD, xcd = wgid % NXCD, off = wgid / NXCD; wgid = (xcd < r ? xcd * (q + 1) : r * (q + 1) + (xcd - r) * q) + off; }
        const int nig = WGM * nN, gid = wgid / nig, fm = gid * WGM, gsz = (nM - fm) < WGM ? (nM - fm) : WGM;
        u.pm = fm + ((wgid % nig) % gsz); u.pn = (wgid % nig) / gsz; return true;
    }
    __device__ __forceinline__ void a_ready(const Unit&) const {}
    __device__ __forceinline__ void done(const Unit&) const {}
};
__device__ __forceinline__ unsigned cvt_pk_bf16(float lo, float hi) { unsigned r; asm volatile("v_cvt_pk_bf16_f32 %0, %1, %2" : "=v"(r) : "v"(lo), "v"(hi)); return r; }
}
namespace pg8 {
constexpr int TOK = 65536;
constexpr size_t TSTRIDE = (size_t)TOK * 1024;
constexpr float QK_C2 = 0.125f * 1.4426950408889634f;
typedef unsigned u32x2 __attribute__((ext_vector_type(2)));
typedef _Float16 h16x2 __attribute__((ext_vector_type(2)));
__device__ __forceinline__ unsigned pk_h2(float lo, float hi) { h16x2 v = {(_Float16)lo, (_Float16)hi}; return __builtin_bit_cast(unsigned, v); }
__device__ __forceinline__ float sigm(float x) { return __builtin_amdgcn_rcpf(1.0f + __expf(-x)); }
__device__ __forceinline__ float silu(float x) { return x * sigm(x); }
__device__ __forceinline__ float row_rstd(const float* ss, int row, float eps) { const f32x4* q = (const f32x4*)(ss + (size_t)row * 16); const f32x4 a = q[0], b = q[1], c = q[2], d = q[3];
    const f32x4 t = (a + b) + (c + d); return rsqrtf(((t[0] + t[1]) + (t[2] + t[3])) * (1.0f / 1024.0f) + eps); }

#define PG8_LOAD_RS(rs8, RS) do { const int sl_ = ((const PG8_LAS unsigned char*)(RS))[u.pm]; const PG8_LAS float* rt_ = (const PG8_LAS float*)((const PG8_LAS unsigned char*)(RS) + 256) + sl_ * 256; \
    _Pragma("unroll") for (int ai = 0; ai < 2; ++ai) _Pragma("unroll") for (int m = 0; m < 4; ++m) rs8[ai * 4 + m] = rt_[ai * HALF + wr * 64 + m * 16 + fr]; } while (0)
struct EpiQKV {
    static constexpr bool PERM = true, AFTER_DRAIN = false;
    bf16_t* P; const PG8_LAS unsigned char* ss; const float* cs;
    __device__ __forceinline__ void operator()(const f32x4 (&acc)[2][2][4][2], const Unit& u, int wr, int wc, int fr, int fq) const {
        const int colt = u.pn * BM, t = colt >> 10;
        bf16_t* base = P + (size_t)t * TSTRIDE;
        const int col0 = (colt & 1023) + wc * 32 + 8 * fq, i0 = (wc & 1) * 16 + 4 * fq;
        const float qs = (t == 0) ? QK_C2 : 1.0f;
        float rs8[8]; PG8_LOAD_RS(rs8, ss);
#pragma unroll
        for (int ai = 0; ai < 2; ++ai) {
            f32x4 c01a[4], c23a[4];
            if (t < 2) {
#pragma unroll
                for (int m = 0; m < 4; ++m) { const float* cp = cs + (size_t)(u.pm * BM + ai * HALF + wr * 64 + m * 16 + fr) * 64 + i0 * 2; c01a[m] = *(const f32x4*)cp; c23a[m] = *(const f32x4*)(cp + 4); }
            }
#pragma unroll
            for (int m = 0; m < 4; ++m) {
                const int row = u.pm * BM + ai * HALF + wr * 64 + m * 16 + fr;
                const float rs = rs8[ai * 4 + m];
                f32x4 c01 = {1.f, 0.f, 1.f, 0.f}, c23 = {1.f, 0.f, 1.f, 0.f};
                if (t < 2) { c01 = c01a[m]; c23 = c23a[m]; }
                bf16_t* rowp = base + (size_t)row * 1024 + col0;
#pragma unroll
                for (int bj = 0; bj < 2; ++bj) {
                    f32x4 v0 = acc[ai][bj][m][0] * rs, v1 = acc[ai][bj][m][1] * rs;
                    if (t < 2) {
                        f32x4 w0, w1;
                        w0[0] = v0[0] * c01[0] - v0[1] * c01[1]; w0[1] = v0[1] * c01[0] + v0[0] * c01[1];
                        w0[2] = v0[2] * c01[2] - v0[3] * c01[3]; w0[3] = v0[3] * c01[2] + v0[2] * c01[3];
                        w1[0] = v1[0] * c23[0] - v1[1] * c23[1]; w1[1] = v1[1] * c23[0] + v1[0] * c23[1];
                        w1[2] = v1[2] * c23[2] - v1[3] * c23[3]; w1[3] = v1[3] * c23[2] + v1[2] * c23[3];
                        v0 = w0 * qs; v1 = w1 * qs;
                    }
                    u32x4 w; w.x = cvt_pk_bf16(v0[0], v0[1]); w.y = cvt_pk_bf16(v0[2], v0[3]); w.z = cvt_pk_bf16(v1[0], v1[1]); w.w = cvt_pk_bf16(v1[2], v1[3]);
                    *(u32x4*)(rowp + bj * HALF) = w;
                }
            }
            asm volatile("" ::: "memory");
        }
    }
};
struct EpiHG {
    static constexpr bool PERM = true, AFTER_DRAIN = false;
    bf16_t* P; const PG8_LAS unsigned char* ss; const float* lb;
    __device__ __forceinline__ void operator()(const f32x4 (&acc)[2][2][4][2], const Unit& u, int wr, int wc, int fr, int fq) const {
        const int colt = u.pn * BM, t = colt >> 10;
        bf16_t* base = P + (size_t)t * TSTRIDE;
        const int col0 = (colt & 1023) + wc * 32 + 8 * fq;
        f32x4 lb0[2] = {{0.f, 0.f, 0.f, 0.f}, {0.f, 0.f, 0.f, 0.f}}, lb1[2] = {{0.f, 0.f, 0.f, 0.f}, {0.f, 0.f, 0.f, 0.f}};
        if (t == 1) {
#pragma unroll
            for (int bj = 0; bj < 2; ++bj) { lb0[bj] = *(const f32x4*)(lb + col0 + bj * HALF); lb1[bj] = *(const f32x4*)(lb + col0 + bj * HALF + 4); }
        }
        float rs8[8]; PG8_LOAD_RS(rs8, ss);
#pragma unroll
        for (int ai = 0; ai < 2; ++ai)
#pragma unroll
            for (int m = 0; m < 4; ++m) {
                const int row = u.pm * BM + ai * HALF + wr * 64 + m * 16 + fr;
                const float rs = rs8[ai * 4 + m];
                bf16_t* rowp = base + (size_t)row * 1024 + col0;
#pragma unroll
                for (int bj = 0; bj < 2; ++bj) {
                    f32x4 v0 = acc[ai][bj][m][0] * rs, v1 = acc[ai][bj][m][1] * rs;
                    u32x4 w;
                    if (t == 1) {
#pragma unroll
                        for (int j = 0; j < 4; ++j) {
                            v0[j] = __logf(lb0[bj][j] + (1.0f - lb0[bj][j]) * sigm(v0[j]));
                            v1[j] = __logf(lb1[bj][j] + (1.0f - lb1[bj][j]) * sigm(v1[j]));
                        }
                        w.x = pk_h2(v0[0], v0[1]); w.y = pk_h2(v0[2], v0[3]); w.z = pk_h2(v1[0], v1[1]); w.w = pk_h2(v1[2], v1[3]);
                    } else {
                        if (t != 2) {
#pragma unroll
                            for (int j = 0; j < 4; ++j) { v0[j] = silu(v0[j]); v1[j] = silu(v1[j]); }
                        }
                        w.x = cvt_pk_bf16(v0[0], v0[1]); w.y = cvt_pk_bf16(v0[2], v0[3]); w.z = cvt_pk_bf16(v1[0], v1[1]); w.w = cvt_pk_bf16(v1[2], v1[3]);
                    }
                    *(u32x4*)(rowp + bj * HALF) = w;
                }
            }
    }
};
struct EpiFFN {
    static constexpr bool PERM = true, AFTER_DRAIN = false;
    bf16_t* H; const PG8_LAS unsigned char* ss;
    __device__ __forceinline__ void operator()(const f32x4 (&acc)[2][2][4][2], const Unit& u, int wr, int wc, int fr, int fq) const {
        const int hcol0 = (u.pn * BM + wc * 32 + 8 * fq) >> 1;
        float rs8[8]; PG8_LOAD_RS(rs8, ss);
#pragma unroll
        for (int ai = 0; ai < 2; ++ai)
#pragma unroll
            for (int m = 0; m < 4; ++m) {
                const int row = u.pm * BM + ai * HALF + wr * 64 + m * 16 + fr;
                const float rs = rs8[ai * 4 + m];
                bf16_t* rowp = H + (size_t)row * 2816 + hcol0;
#pragma unroll
                for (int bj = 0; bj < 2; ++bj) {
                    const f32x4 v0 = acc[ai][bj][m][0] * rs, v1 = acc[ai][bj][m][1] * rs;
                    u32x2 w; w.x = cvt_pk_bf16(silu(v0[0]) * v0[1], silu(v0[2]) * v0[3]); w.y = cvt_pk_bf16(silu(v1[0]) * v1[1], silu(v1[2]) * v1[3]);
                    *(u32x2*)(rowp + bj * 64) = w;
                }
            }
    }
};
__device__ __forceinline__ float bfl(unsigned w) { return __builtin_bit_cast(float, w << 16); }
__device__ __forceinline__ float bfh(unsigned w) { return __builtin_bit_cast(float, w & 0xffff0000u); }
struct EpiRes {
    static constexpr bool PERM = true, AFTER_DRAIN = false;
    bf16_t* xn; float* ssn;
    __device__ __forceinline__ void operator()(const f32x4 (&acc)[2][2][4][2], const Unit& u, int wr, int wc, int fr, int fq) const {
        const int col0 = u.pn * BM + wc * 32 + 8 * fq;
#pragma unroll
        for (int ai = 0; ai < 2; ++ai) {
            u32x4 bres[4][2];
#pragma unroll
            for (int m = 0; m < 4; ++m)
#pragma unroll
                for (int bj = 0; bj < 2; ++bj) bres[m][bj] = *(const u32x4*)(xn + (size_t)(u.pm * BM + ai * HALF + wr * 64 + m * 16 + fr) * 1024 + col0 + bj * HALF);
#pragma unroll
            for (int m = 0; m < 4; ++m) {
                const int row = u.pm * BM + ai * HALF + wr * 64 + m * 16 + fr;
                bf16_t* rowp = xn + (size_t)row * 1024 + col0;
                float s = 0.f;
#pragma unroll
                for (int bj = 0; bj < 2; ++bj) {
                    const u32x4 b = bres[m][bj];
                    const f32x4 v0 = acc[ai][bj][m][0] + (f32x4){bfl(b.x), bfh(b.x), bfl(b.y), bfh(b.y)}, v1 = acc[ai][bj][m][1] + (f32x4){bfl(b.z), bfh(b.z), bfl(b.w), bfh(b.w)};
                    u32x4 w; w.x = cvt_pk_bf16(v0[0], v0[1]); w.y = cvt_pk_bf16(v0[2], v0[3]); w.z = cvt_pk_bf16(v1[0], v1[1]); w.w = cvt_pk_bf16(v1[2], v1[3]);
                    *(u32x4*)(rowp + bj * HALF) = w;
                    s += (bfl(w.x) * bfl(w.x) + bfh(w.x) * bfh(w.x)) + (bfl(w.y) * bfl(w.y) + bfh(w.y) * bfh(w.y));
                    s += (bfl(w.z) * bfl(w.z) + bfh(w.z) * bfh(w.z)) + (bfl(w.w) * bfl(w.w) + bfh(w.w) * bfh(w.w));
                }
                s += __shfl_xor(s, 16); s += __shfl_xor(s, 32);
                if (fq == 0) ssn[(size_t)row * 16 + u.pn * 4 + wc] = s;
            }
        }
    }
};
}
namespace pg8 {
template <class Epi, class Sched, bool ALIGN_EPI = false, bool SP2 = false>
__device__ __forceinline__ void gemm_phase(PG8_LAS unsigned char* lds, const Gemm g, const Sched& S, const Epi& E) {
    const int tid = mk_tid(), wid = __builtin_amdgcn_readfirstlane(tid >> 6), lane = tid & 63, wr = wid >> 2, wc = wid & 3, fr = lane & 15, fq = lane >> 4;
    const int K = g.K, nt = K / BK;
    unsigned voffA[2], voffB[2];
#pragma unroll
    for (int i = 0; i < 2; ++i) { int R, C; stage_rc(tid * 16 + i * 8192, R, C); const int Rb = Epi::PERM ? ((R & ~31) + perm32(R & 31)) : R;
        voffA[i] = (unsigned)(R * K + C) * 2u; voffB[i] = (unsigned)(Rb * K + C) * 2u; }
    const size_t kstep = (size_t)(BK * 2);
    const size_t hstep = (size_t)HALF * K * 2;
    const size_t tstep = 2 * hstep;
    const unsigned ldsw = (unsigned)wid * 1024u;
    const int aoff = lds_byte(wr * 64 + fr, fq * 8), boff = lds_byte(wc * 32 + fr, fq * 8);
#define PG8_SA(b, h) (((b) * 2 + (h)) * HTB)
#define PG8_SB(b, h) ((4 + (b) * 2 + (h)) * HTB)
#define PG8_STAGE(bufoff, gbase, voff) do { _Pragma("unroll") for (int _i = 0; _i < 2; ++_i) \
        __builtin_amdgcn_global_load_lds((const unsigned*)((const char*)(gbase) + (voff)[_i]), (PG8_LAS unsigned*)(lds + (bufoff) + ldsw + _i * 8192), 16, 0, 0); } while (0)
#define PG8_LDA(dst, b, h) do { _Pragma("unroll") for (int m = 0; m < 4; ++m) _Pragma("unroll") for (int k = 0; k < 2; ++k) dst[m][k] = *(const PG8_LAS bf16x8*)(lds + PG8_SA(b, h) + aoff + m * 2048 + k * 1024); } while (0)
#define PG8_LDB(dst, b, h) do { _Pragma("unroll") for (int n = 0; n < 2; ++n) _Pragma("unroll") for (int k = 0; k < 2; ++k) dst[n][k] = *(const PG8_LAS bf16x8*)(lds + PG8_SB(b, h) + boff + n * 2048 + k * 1024); } while (0)
#define PG8_MMA(ai, bj, At, Bt) do { __builtin_amdgcn_s_setprio(1); _Pragma("unroll") for (int m = 0; m < 4; ++m) _Pragma("unroll") for (int n = 0; n < 2; ++n) _Pragma("unroll") for (int k = 0; k < 2; ++k) \
        acc[ai][bj][m][n] = __builtin_amdgcn_mfma_f32_16x16x32_bf16(Bt[n][k], At[m][k], acc[ai][bj][m][n], 0, 0, 0); __builtin_amdgcn_s_setprio(0); } while (0)
#define PG8_WAIT_V(n) asm volatile("s_waitcnt vmcnt(" #n ")" ::: "memory")
#define PG8_WAIT_L(n) asm volatile("s_waitcnt lgkmcnt(" #n ")" ::: "memory")
#define PG8_BAR __builtin_amdgcn_s_barrier()
#define PG8_SCHED __builtin_amdgcn_sched_barrier(0)
    Unit cur, nxt; int ui = 0;
    if (!S.next(0, cur)) return;
    f32x4 acc[2][2][4][2];
#pragma unroll
    for (int a = 0; a < 2; ++a)
#pragma unroll
        for (int b = 0; b < 2; ++b)
#pragma unroll
            for (int m = 0; m < 4; ++m)
#pragma unroll
                for (int n = 0; n < 2; ++n) acc[a][b][m][n] = (f32x4){0.f, 0.f, 0.f, 0.f};
    bf16x8 At[4][2], B0[2][2], B1[2][2];
    const char* cA = (const char*)g.A + (size_t)cur.pm * tstep; const char* cB = (const char*)g.Bt + (size_t)cur.pn * tstep;
    S.a_ready(cur);
    if constexpr (SP2) {
        PG8_STAGE(PG8_SB(0, 0), cB, voffB); PG8_STAGE(PG8_SB(0, 1), cB + hstep, voffB); PG8_STAGE(PG8_SA(0, 0), cA, voffA); PG8_STAGE(PG8_SA(0, 1), cA + hstep, voffA);
        if (wr == 1) PG8_BAR;
        PG8_WAIT_V(2); PG8_BAR;
        PG8_STAGE(PG8_SB(1, 0), cB + kstep, voffB); PG8_STAGE(PG8_SA(1, 0), cA + kstep, voffA); PG8_STAGE(PG8_SB(1, 1), cB + hstep + kstep, voffB);
        PG8_WAIT_V(6); PG8_BAR;
    } else {
        PG8_STAGE(PG8_SB(0, 0), cB, voffB); PG8_STAGE(PG8_SA(0, 0), cA, voffA); PG8_STAGE(PG8_SB(0, 1), cB + hstep, voffB); PG8_STAGE(PG8_SA(0, 1), cA + hstep, voffA);
        if (wr == 1) PG8_BAR;
        PG8_WAIT_V(4); PG8_BAR;
        PG8_STAGE(PG8_SB(1, 0), cB + kstep, voffB); PG8_STAGE(PG8_SA(1, 0), cA + kstep, voffA); PG8_STAGE(PG8_SB(1, 1), cB + hstep + kstep, voffB);
        PG8_WAIT_V(6); PG8_BAR;
    }
    for (;;) {
        const bool has_next = S.next(ui + 1, nxt);
        const char* nA = has_next ? (const char*)g.A + (size_t)nxt.pm * tstep : cA; const char* nB = has_next ? (const char*)g.Bt + (size_t)nxt.pn * tstep : cB;
        for (int t = 0; t < nt; t += 2) {
            const bool last = (t == nt - 2);
            const char* a1 = cA + (size_t)(t + 1) * kstep;
            const char* a2 = last ? nA : cA + (size_t)(t + 2) * kstep; const char* b2 = last ? nB : cB + (size_t)(t + 2) * kstep;
            const char* a3 = a2 + kstep; const char* b3 = b2 + kstep;
            if (last && has_next) S.a_ready(nxt);
            if constexpr (SP2) {
            PG8_LDB(B0, 0, 0); PG8_LDB(B1, 0, 1); PG8_SCHED; PG8_LDA(At, 0, 0); PG8_STAGE(PG8_SA(1, 1), a1 + hstep, voffA);
            PG8_WAIT_V(8); PG8_WAIT_L(0); PG8_BAR; PG8_MMA(0, 0, At, B0); PG8_MMA(0, 1, At, B1); PG8_BAR; PG8_SCHED;
            PG8_LDA(At, 0, 1); PG8_STAGE(PG8_SB(0, 0), b2, voffB); PG8_STAGE(PG8_SB(0, 1), b2 + hstep, voffB); PG8_STAGE(PG8_SA(0, 0), a2, voffA);
            PG8_WAIT_V(8); PG8_WAIT_L(0); PG8_BAR; PG8_MMA(1, 0, At, B0); PG8_MMA(1, 1, At, B1); PG8_BAR; PG8_SCHED;
            PG8_LDB(B0, 1, 0); PG8_LDB(B1, 1, 1); PG8_SCHED; PG8_LDA(At, 1, 0); PG8_STAGE(PG8_SA(0, 1), a2 + hstep, voffA);
            PG8_WAIT_V(8); PG8_WAIT_L(0); PG8_BAR; PG8_MMA(0, 0, At, B0); PG8_MMA(0, 1, At, B1); PG8_BAR; PG8_SCHED;
            PG8_LDA(At, 1, 1); PG8_STAGE(PG8_SB(1, 0), b3, voffB); PG8_STAGE(PG8_SB(1, 1), b3 + hstep, voffB); PG8_STAGE(PG8_SA(1, 0), a3, voffA);
            PG8_WAIT_V(8); PG8_WAIT_L(0); PG8_BAR; PG8_MMA(1, 0, At, B0); PG8_MMA(1, 1, At, B1); PG8_BAR; PG8_SCHED;
            } else {
            PG8_LDB(B0, 0, 0); PG8_SCHED; PG8_LDA(At, 0, 0); PG8_STAGE(PG8_SA(1, 1), a1 + hstep, voffA);
            PG8_WAIT_L(8); PG8_BAR; PG8_WAIT_L(0); PG8_MMA(0, 0, At, B0); PG8_BAR; PG8_SCHED;
            PG8_LDB(B1, 0, 1); PG8_STAGE(PG8_SB(0, 0), b2, voffB);
            PG8_BAR; PG8_WAIT_L(0); PG8_MMA(0, 1, At, B1); PG8_BAR;
            PG8_LDA(At, 0, 1); PG8_STAGE(PG8_SA(0, 0), a2, voffA);
            PG8_BAR; PG8_WAIT_L(0); PG8_MMA(1, 0, At, B0); PG8_BAR; PG8_SCHED;
            PG8_STAGE(PG8_SB(0, 1), b2 + hstep, voffB);
            PG8_WAIT_V(6); PG8_BAR; PG8_MMA(1, 1, At, B1); PG8_BAR;
            PG8_LDB(B0, 1, 0); PG8_SCHED; PG8_LDA(At, 1, 0); PG8_STAGE(PG8_SA(0, 1), a2 + hstep, voffA);
            PG8_WAIT_L(8); PG8_BAR; PG8_WAIT_L(0); PG8_MMA(0, 0, At, B0); PG8_BAR; PG8_SCHED;
            PG8_LDB(B1, 1, 1); PG8_STAGE(PG8_SB(1, 0), b3, voffB);
            PG8_BAR; PG8_WAIT_L(0); PG8_MMA(0, 1, At, B1); PG8_BAR;
            PG8_LDA(At, 1, 1); PG8_STAGE(PG8_SA(1, 0), a3, voffA);
            PG8_BAR; PG8_WAIT_L(0); PG8_MMA(1, 0, At, B0); PG8_BAR; PG8_SCHED;
            PG8_STAGE(PG8_SB(1, 1), b3 + hstep, voffB);
            PG8_WAIT_V(6); PG8_BAR; PG8_MMA(1, 1, At, B1); PG8_BAR;
            }
        }
        if constexpr (ALIGN_EPI) { if (wr == 0) PG8_BAR; }
        if constexpr (!Epi::AFTER_DRAIN) { E(acc, cur, wr, wc, fr, fq); S.done(cur); }
        if (!has_next) break;
#pragma unroll
        for (int a = 0; a < 2; ++a)
#pragma unroll
            for (int b = 0; b < 2; ++b)
#pragma unroll
                for (int m = 0; m < 4; ++m)
#pragma unroll
                    for (int n = 0; n < 2; ++n) acc[a][b][m][n] = (f32x4){0.f, 0.f, 0.f, 0.f};
        cur = nxt; cA = nA; cB = nB; ++ui;
        if constexpr (ALIGN_EPI) { if (wr == 1) PG8_BAR; }
    }
    PG8_WAIT_V(0);
    if constexpr (!ALIGN_EPI) { if (wr == 0) PG8_BAR; }
    PG8_BAR;
    if constexpr (Epi::AFTER_DRAIN) { E.fused(acc, cur, wr, wc, fr, fq, lds, wid, lane); S.done(cur); }
#undef PG8_SA
#undef PG8_SB
#undef PG8_STAGE
#undef PG8_LDA
#undef PG8_LDB
#undef PG8_MMA
#undef PG8_WAIT_V
#undef PG8_WAIT_L
#undef PG8_BAR
#undef PG8_SCHED
}
}
namespace attn_body {
using bf16=__hip_bfloat16;
using bf16x8=__attribute__((ext_vector_type(8)))short;
using s16x4=__attribute__((ext_vector_type(4)))short;
using f32x16=__attribute__((ext_vector_type(16)))float;
using u32x4=__attribute__((ext_vector_type(4)))unsigned;
constexpr int SEQ=4096,D=64,DM=1024;
constexpr int NW=8,QBLK=32,QB=QBLK*NW,KVBLK=64,NQB=SEQ/QB;
constexpr int ATTN_PITCH=DM, ATTN_UNIT_ROWS=QB;
__device__ __forceinline__ int crow(int r,int hi){return (r&3)+8*(r>>2)+4*hi;}
#define SBAR() __builtin_amdgcn_sched_barrier(0)
__device__ __forceinline__ void cmask(f32x16&p0,f32x16&p1,int jb,int qrel,int hi){
  const float NEG=-INFINITY; int kb=64*jb+4*hi;
  #pragma unroll
  for(int r=0;r<16;++r){int kv=kb+(r&3)+8*(r>>2); if(kv>qrel)p0[r]=NEG; if(kv+32>qrel)p1[r]=NEG;}
}

constexpr int NSLOT=3, SLOTB=8192;
constexpr int LDS_K=0, LDS_V=NSLOT*SLOTB, LDS_WS=2*NSLOT*SLOTB, LDS_OST=LDS_WS+NW*64*4, LDS_BYTES=LDS_OST+NW*4096;
constexpr float C2=0.125f*1.4426950408889634f;
__device__ __forceinline__ void glds16(const void*gsrc,unsigned lds_dst){unsigned keep;
  asm volatile("s_mov_b32 %0, m0\n\ts_mov_b32 m0, %2\n\ts_nop 0\n\tglobal_load_lds_dwordx4 %1, off\n\ts_mov_b32 m0, %0":"=&s"(keep):"v"(gsrc),"s"(lds_dst):"memory");}
__device__ __forceinline__ float max3f(float a,float b,float c){float r;asm("v_max3_f32 %0, %1, %2, %3":"=v"(r):"v"(a),"v"(b),"v"(c));return r;}
__device__ __forceinline__ float max2f(float a,float b){float r;asm("v_max_f32_e32 %0, %1, %2":"=v"(r):"v"(a),"v"(b));return r;}
__device__ __forceinline__ float fadd_s(float a,float b){float r;asm("v_add_f32_e32 %0, %1, %2":"=v"(r):"v"(a),"v"(b));return r;}
__device__ __forceinline__ float fsub_s(float a,float b){float r;asm("v_sub_f32_e32 %0, %1, %2":"=v"(r):"v"(a),"v"(b));return r;}
typedef float f32x2_t __attribute__((ext_vector_type(2))); typedef __bf16 bf16x2_t __attribute__((ext_vector_type(2)));
__device__ __forceinline__ unsigned cvtpk_s(float lo,float hi){f32x2_t v={lo,hi};bf16x2_t b=__builtin_convertvector(v,bf16x2_t);return __builtin_bit_cast(unsigned,b);}
#define WAIT_BAR(N) asm volatile("s_waitcnt vmcnt(" #N ") lgkmcnt(0)\n\ts_barrier":::"memory")

__device__ __forceinline__ void qkt(f32x16&p0,f32x16&p1,const char*Kslot,const bf16x8*qr,const f32x16&negm,int r32,int hi){
  const char*kb=Kslot+hi*1024+r32*16;
  #pragma unroll
  for(int d0=0;d0<4;++d0){
    const bf16x8 b0=*reinterpret_cast<const bf16x8*>(kb+d0*2048);
    const bf16x8 b1=*reinterpret_cast<const bf16x8*>(kb+d0*2048+512);
    if(d0==0){p0=__builtin_amdgcn_mfma_f32_32x32x16_bf16(b0,qr[0],negm,0,0,0);p1=__builtin_amdgcn_mfma_f32_32x32x16_bf16(b1,qr[0],negm,0,0,0);}
    else{p0=__builtin_amdgcn_mfma_f32_32x32x16_bf16(b0,qr[d0],p0,0,0,0);p1=__builtin_amdgcn_mfma_f32_32x32x16_bf16(b1,qr[d0],p1,0,0,0);}}
}
typedef __attribute__((address_space(3))) const char* lds_cptr;
typedef short v4i16_t __attribute__((ext_vector_type(4)));
__device__ __forceinline__ void kload8(bf16x8*kf,lds_cptr kp){
  kf[0]=*(const __attribute__((address_space(3))) bf16x8*)(kp);      kf[1]=*(const __attribute__((address_space(3))) bf16x8*)(kp+512);
  kf[2]=*(const __attribute__((address_space(3))) bf16x8*)(kp+2048); kf[3]=*(const __attribute__((address_space(3))) bf16x8*)(kp+2560);
  kf[4]=*(const __attribute__((address_space(3))) bf16x8*)(kp+4096); kf[5]=*(const __attribute__((address_space(3))) bf16x8*)(kp+4608);
  kf[6]=*(const __attribute__((address_space(3))) bf16x8*)(kp+6144); kf[7]=*(const __attribute__((address_space(3))) bf16x8*)(kp+6656);
}
__device__ __forceinline__ void kload2(bf16x8*kf,lds_cptr kp,int j){ kf[2*j]=*(const __attribute__((address_space(3))) bf16x8*)(kp+j*2048); kf[2*j+1]=*(const __attribute__((address_space(3))) bf16x8*)(kp+j*2048+512); }
__device__ __forceinline__ s16x4 vtr(lds_cptr p){ return __builtin_bit_cast(s16x4,__builtin_amdgcn_ds_read_tr16_b64_v4i16((__attribute__((address_space(3))) v4i16_t*)p)); }
__device__ __forceinline__ float rowmax(const f32x16&p0,const f32x16&p1){
  float a=max3f(p0[0],p0[1],p1[0]),b=max3f(p0[2],p0[3],p1[1]);a=max3f(a,p1[2],p1[3]);
  #pragma unroll
  for(int r=4;r<16;r+=4){a=max3f(a,p0[r],p0[r+1]);b=max3f(b,p0[r+2],p0[r+3]);a=max3f(a,p1[r],p1[r+1]);b=max3f(b,p1[r+2],p1[r+3]);}
  const float m=max2f(a,b);
  auto rr=__builtin_amdgcn_permlane32_swap(__float_as_uint(m),__float_as_uint(m),false,false);
  return max2f(__uint_as_float(rr[0]),__uint_as_float(rr[1]));
}
__device__ __forceinline__ void pv(f32x16*o,int vb,bf16x8 pa0,bf16x8 pa1,bf16x8 pa2,bf16x8 pa3){
  #pragma unroll
  for(int d0=0;d0<2;++d0){s16x4 lo[4],hi[4];
    #pragma unroll
    for(int ks=0;ks<4;++ks){
      asm volatile("ds_read_b64_tr_b16 %0,%1 offset:%c2":"=&v"(lo[ks]):"v"(vb),"i"(d0*4096+ks*1024):"memory");
      asm volatile("ds_read_b64_tr_b16 %0,%1 offset:%c2":"=&v"(hi[ks]):"v"(vb),"i"(d0*4096+ks*1024+512):"memory");}
    asm volatile("s_waitcnt lgkmcnt(0)":::"memory");SBAR();
    #define PK(k) (bf16x8){lo[k][0],lo[k][1],lo[k][2],lo[k][3],hi[k][0],hi[k][1],hi[k][2],hi[k][3]}
    o[d0]=__builtin_amdgcn_mfma_f32_32x32x16_bf16(pa0,PK(0),o[d0],0,0,0);
    o[d0]=__builtin_amdgcn_mfma_f32_32x32x16_bf16(pa1,PK(1),o[d0],0,0,0);
    o[d0]=__builtin_amdgcn_mfma_f32_32x32x16_bf16(pa2,PK(2),o[d0],0,0,0);
    o[d0]=__builtin_amdgcn_mfma_f32_32x32x16_bf16(pa3,PK(3),o[d0],0,0,0);
    #undef PK
  }
}

#ifndef ATTN_STORE16
#define ATTN_STORE16(p,v) (*(u32x4*)(p)=(v))
#endif
template<int THRL> __device__ __forceinline__ void attn_unit(int b,int qcol,int vcol,int qb,const bf16*Q,const bf16*__restrict__ K,const bf16*__restrict__ V,bf16*O,char*shm){
  const int tid=mk_tid(),lane=tid&63,r32=lane&31,hi=lane>>5; const int wid=__builtin_amdgcn_readfirstlane(tid>>6);
  const long rowbase=(long)b*SEQ; const int q0=qb*QB;
  const bf16*Qw=Q+(rowbase+q0+wid*QBLK)*DM+qcol;
  const bf16*Kh=K+rowbase*DM+qcol,*Vh=V+rowbase*DM+vcol;
  const unsigned lds0=(unsigned)(uintptr_t)shm;
  float*wsf=(float*)(shm+LDS_WS)+wid*64;
  const bf16*ksrc=Kh+(long)lane*DM+wid*8;
  const bf16*vsrc=Vh+(long)(16*(wid&3)+(lane>>2))*DM+(wid>>2)*32+(lane&3)*8;
  const unsigned kdst=lds0+LDS_K+wid*1024, vdst=lds0+LDS_V+wid*1024;
  #define DMA_K(t,slot) glds16(ksrc+(long)(t)*KVBLK*DM,(unsigned)__builtin_amdgcn_readfirstlane(kdst+(slot)))
  #define DMA_V(t,slot) glds16(vsrc+(long)(t)*KVBLK*DM,(unsigned)__builtin_amdgcn_readfirstlane(vdst+(slot)))
  const int vb0=(int)(lds0+LDS_V)+((lane>>4)&1)*32+(lane&3)*8+(4*hi+((lane&15)>>2))*64;
  const char*Kbase=shm+LDS_K; bf16x8 kf[8];
  const lds_cptr shm3=(lds_cptr)shm; const lds_cptr kp0=shm3+LDS_K+hi*1024+r32*16; const lds_cptr vp0=shm3+LDS_V+((lane>>4)&1)*32+(lane&3)*8+(4*hi+((lane&15)>>2))*64;
  const int NT=(q0+QB)/KVBLK;
  DMA_K(0,0);DMA_V(0,0);DMA_K(1,SLOTB);
  bf16x8 qr[4];
  #pragma unroll
  for(int d0=0;d0<4;++d0)qr[d0]=*reinterpret_cast<const bf16x8*>(&Qw[(long)r32*DM+d0*16+hi*8]);
  float mhat=0.f,l_reg=0.f;f32x16 o[2];o[0]=f32x16{};o[1]=f32x16{};f32x16 negm=f32x16{};asm volatile("":"+v"(negm));
  const int qrel=wid*QBLK+r32;
  #define CMASK(P0,P1,t) do{int jb_=(t)-(NT-4); if(jb_>=0)cmask(P0,P1,jb_,qrel,hi);}while(0)
  bool resc=false;
  #define START(P0,P1) do{ const float rm=rowmax(P0,P1); resc=false; \
    { const float dl=rm; mhat=fadd_s(mhat,dl); \
      _Pragma("unroll") for(int r=0;r<16;++r){P0[r]=fsub_s(P0[r],dl);P1[r]=fsub_s(P1[r],dl);} \
      _Pragma("unroll") for(int r=0;r<16;++r)negm[r]=-mhat; asm volatile("":"+v"(negm)); } \
    _Pragma("unroll") for(int r=0;r<16;++r)P0[r]=__builtin_amdgcn_exp2f(P0[r]); }while(0)
  #define RESC() do{ if(resc){ asm volatile("s_waitcnt lgkmcnt(0)":::"memory"); \
      _Pragma("unroll") for(int d_=0;d_<2;++d_) _Pragma("unroll") for(int r=0;r<16;++r)o[d_][r]*=wsf[crow(r,hi)]; } }while(0)
  f32x16 pA0,pA1,pB0,pB1;
  int sl_prev=0,sl_cur=0,sl_next=SLOTB;
  #define ROT() do{sl_prev=sl_cur;sl_cur=sl_next;sl_next=(sl_next==(NSLOT-1)*SLOTB)?0:sl_next+SLOTB;}while(0)
  DMA_K(2,2*SLOTB);
  WAIT_BAR(3);
  qkt(pA0,pA1,Kbase,qr,negm,r32,hi);asm volatile("s_nop 15\n\ts_nop 7":"+v"(pA0),"+v"(pA1));CMASK(pA0,pA1,0);
  START(pA0,pA1);
  _Pragma("unroll") for(int r=0;r<16;++r)pA1[r]=__builtin_amdgcn_exp2f(pA1[r]);
  WAIT_BAR(0);
  DMA_K(3,0);DMA_V(1,SLOTB);
  ROT();
  kload8(kf,kp0+sl_cur);
  WAIT_BAR(2);
  s16x4 vlo[8],vhi[8]; u32x4 pw0,pw1,pw2,pw3;
  #define PKW(P,B) cvtpk_s(P[B],P[B+1])
  #define PAF(k) __builtin_bit_cast(bf16x8,pw##k)
  #define VFR(i) (bf16x8){vlo[i][0],vlo[i][1],vlo[i][2],vlo[i][3],vhi[i][0],vhi[i][1],vhi[i][2],vhi[i][3]}
  #define PIN(x) asm volatile("":"+v"(x))
  #define MX3(a,b,c) __builtin_fmaxf(__builtin_fmaxf((a),(b)),(c))
  #define GAPA(MF,A0,A1,A2,A3,W0,W1,PW) do{ MF; sacc+=A0; sacc+=A1; sacc+=A2; sacc+=A3; PIN(sacc); W0; W1; PIN(PW); SBAR(); }while(0)
  #define EX(v) __builtin_amdgcn_exp2f(v)
  #define GAPB(MF,X,B) do{ MF; X[B]=EX(X[B]); X[B+1]=EX(X[B+1]); X[B+2]=EX(X[B+2]); X[B+3]=EX(X[B+3]); PIN(X); SBAR(); }while(0)
  #define VRD(i) do{ vlo[i]=vtr(vp_+(((i)>>2)*4096+((i)&3)*1024)); vhi[i]=vtr(vp_+(((i)>>2)*4096+((i)&3)*1024+512)); }while(0)
  #define KRD(G,j) do{ if(G){ kload2(kf,kp0+sl_next,j); SBAR(); } }while(0)
  #define STEP(C0,C1,P0,P1,t,GK,GV,GL) do{ SBAR(); \
    const lds_cptr vp_=vp0+sl_prev; \
    VRD(0); SBAR(); float sacc=(P0[0]+P0[1]); \
    GAPA(C0=__builtin_amdgcn_mfma_f32_32x32x16_bf16(kf[0],qr[0],negm,0,0,0), P0[2],P0[3],P0[4],P0[5],     pw0[0]=PKW(P0,0), pw0[1]=PKW(P0,2), pw0); \
    VRD(4); SBAR(); GAPA(C1=__builtin_amdgcn_mfma_f32_32x32x16_bf16(kf[1],qr[0],negm,0,0,0), P0[6],P0[7],P0[8],P0[9],     pw0[2]=PKW(P0,4), pw0[3]=PKW(P0,6), pw0); \
    VRD(1); SBAR(); GAPA(C0=__builtin_amdgcn_mfma_f32_32x32x16_bf16(kf[2],qr[1],C0,0,0,0),   P0[10],P0[11],P0[12],P0[13], pw1[0]=PKW(P0,8), pw1[1]=PKW(P0,10), pw1); \
    VRD(5); SBAR(); GAPA(C1=__builtin_amdgcn_mfma_f32_32x32x16_bf16(kf[3],qr[1],C1,0,0,0),   P0[14],P0[15],P1[0],P1[1],   pw1[2]=PKW(P0,12),pw1[3]=PKW(P0,14), pw1); \
    VRD(2); SBAR(); GAPA(C0=__builtin_amdgcn_mfma_f32_32x32x16_bf16(kf[4],qr[2],C0,0,0,0),   P1[2],P1[3],P1[4],P1[5],     pw2[0]=PKW(P1,0), pw2[1]=PKW(P1,2), pw2); \
    VRD(6); SBAR(); GAPA(C1=__builtin_amdgcn_mfma_f32_32x32x16_bf16(kf[5],qr[2],C1,0,0,0),   P1[6],P1[7],P1[8],P1[9],     pw2[2]=PKW(P1,4), pw2[3]=PKW(P1,6), pw2); \
    VRD(3); SBAR(); GAPA(C0=__builtin_amdgcn_mfma_f32_32x32x16_bf16(kf[6],qr[3],C0,0,0,0),   P1[10],P1[11],P1[12],P1[13], pw3[0]=PKW(P1,8), pw3[1]=PKW(P1,10), pw3); \
    VRD(7); SBAR(); GAPA(C1=__builtin_amdgcn_mfma_f32_32x32x16_bf16(kf[7],qr[3],C1,0,0,0),   P1[14],P1[15],0.f,0.f,       pw3[2]=PKW(P1,12),pw3[3]=PKW(P1,14), pw3); \
    l_reg+=sacc; \
    if(GK){DMA_K((t)+3,sl_cur);} if(GV){DMA_V((t)+1,sl_next);} \
    CMASK(C0,C1,t); \
    { float a=MX3(C0[0],C0[1],C1[0]),b=MX3(C0[2],C0[3],C1[1]); a=MX3(a,C1[2],C1[3]); \
      _Pragma("unroll") for(int r=4;r<16;r+=4){a=MX3(a,C0[r],C0[r+1]);b=MX3(b,C0[r+2],C0[r+3]);a=MX3(a,C1[r],C1[r+1]);b=MX3(b,C1[r+2],C1[r+3]);} \
      float rm=__builtin_fmaxf(a,b); { auto rr=__builtin_amdgcn_permlane32_swap(__float_as_uint(rm),__float_as_uint(rm),false,false); rm=__builtin_fmaxf(__uint_as_float(rr[0]),__uint_as_float(rr[1])); } \
      resc=false; \
      if(__builtin_expect(__any(rm>(float)THRL),0)){ const float dl=__builtin_fmaxf(rm,0.f); mhat+=dl; \
        _Pragma("unroll") for(int r=0;r<16;++r){C0[r]-=dl;C1[r]-=dl;} \
        _Pragma("unroll") for(int r=0;r<16;++r)negm[r]=-mhat; asm volatile("":"+v"(negm)); \
        const float f=__builtin_amdgcn_exp2f(-dl); l_reg*=f; if(hi==0)wsf[r32]=f; resc=true; } } \
    SBAR(); \
    GAPB(o[0]=__builtin_amdgcn_mfma_f32_32x32x16_bf16(PAF(0),VFR(0),o[0],0,0,0), C0,0); \
    GAPB(o[1]=__builtin_amdgcn_mfma_f32_32x32x16_bf16(PAF(0),VFR(4),o[1],0,0,0), C0,4); \
    KRD(GL,0); GAPB(o[0]=__builtin_amdgcn_mfma_f32_32x32x16_bf16(PAF(1),VFR(1),o[0],0,0,0), C0,8); \
    KRD(GL,1); GAPB(o[1]=__builtin_amdgcn_mfma_f32_32x32x16_bf16(PAF(1),VFR(5),o[1],0,0,0), C0,12); \
    KRD(GL,2); GAPB(o[0]=__builtin_amdgcn_mfma_f32_32x32x16_bf16(PAF(2),VFR(2),o[0],0,0,0), C1,0); \
    KRD(GL,3); GAPB(o[1]=__builtin_amdgcn_mfma_f32_32x32x16_bf16(PAF(2),VFR(6),o[1],0,0,0), C1,4); \
    GAPB(o[0]=__builtin_amdgcn_mfma_f32_32x32x16_bf16(PAF(3),VFR(3),o[0],0,0,0), C1,8); \
    GAPB(o[1]=__builtin_amdgcn_mfma_f32_32x32x16_bf16(PAF(3),VFR(7),o[1],0,0,0), C1,12); \
    }while(0)
  int t=1;
  #undef CMASK
  #define CMASK(P0,P1,t) do{}while(0)
  for(;t+5<NT;t+=2){
    STEP(pB0,pB1,pA0,pA1,t,true,true,true);     WAIT_BAR(2); RESC(); ROT();
    STEP(pA0,pA1,pB0,pB1,t+1,true,true,true);   WAIT_BAR(2); RESC(); ROT();
  }
  #undef CMASK
  #define CMASK(P0,P1,t) do{int jb_=(t)-(NT-4); if(jb_>=0)cmask(P0,P1,jb_,qrel,hi);}while(0)
  #define ENDW(tt) do{ if((tt)+3<NT){WAIT_BAR(2);} else if((tt)+2<NT){WAIT_BAR(1);} else {WAIT_BAR(0);} }while(0)
  for(;t+1<NT;t+=2){
    STEP(pB0,pB1,pA0,pA1,t,(t+3<NT),(t+1<NT),(t+1<NT));       ENDW(t);   RESC(); ROT();
    STEP(pA0,pA1,pB0,pB1,t+1,(t+4<NT),(t+2<NT),(t+2<NT));     ENDW(t+1); RESC(); ROT();
  }
  STEP(pB0,pB1,pA0,pA1,NT-1,false,false,false); RESC();
  { float sacc=pB0[0]+pB0[1]; _Pragma("unroll") for(int r=2;r<16;++r)sacc+=pB0[r]; _Pragma("unroll") for(int r=0;r<16;++r)sacc+=pB1[r]; l_reg+=sacc;
    pw0=(u32x4){PKW(pB0,0),PKW(pB0,2),PKW(pB0,4),PKW(pB0,6)};pw1=(u32x4){PKW(pB0,8),PKW(pB0,10),PKW(pB0,12),PKW(pB0,14)};pw2=(u32x4){PKW(pB1,0),PKW(pB1,2),PKW(pB1,4),PKW(pB1,6)};pw3=(u32x4){PKW(pB1,8),PKW(pB1,10),PKW(pB1,12),PKW(pB1,14)};
    SBAR(); pv(o,vb0+sl_cur,PAF(0),PAF(1),PAF(2),PAF(3)); }
  #undef PKW
  #undef PAF
  #undef VFR
  #undef PIN
  #undef MX3
  #undef GAPA
  #undef GAPB
  #undef EX
  #undef VRD
  #undef KRD
  #undef STEP
  #undef ENDW
  {auto rr=__builtin_amdgcn_permlane32_swap(__float_as_uint(l_reg),__float_as_uint(l_reg),false,false);l_reg=__uint_as_float(rr[0])+__uint_as_float(rr[1]);}
  if(hi==0)wsf[32+r32]=l_reg;asm volatile("s_waitcnt lgkmcnt(0)":::"memory");
  float rli[16];
  #pragma unroll
  for(int r=0;r<16;++r)rli[r]=__builtin_amdgcn_rcpf(wsf[32+crow(r,hi)]);
  bf16*Ow=O+(rowbase+q0+wid*QBLK)*DM+vcol;
  { _Float16*stg=(_Float16*)(shm+LDS_OST)+wid*2048;
    #pragma unroll
    for(int r=0;r<16;++r){const int orow=crow(r,hi);
      #pragma unroll
      for(int d0=0;d0<2;++d0)stg[orow*64+d0*32+r32]=(_Float16)(o[d0][r]*rli[r]);}
    asm volatile("s_waitcnt lgkmcnt(0)":::"memory");
    #pragma unroll
    for(int i=0;i<4;++i){const int row=i*8+(lane>>3),ch=lane&7; const u32x4 v=*(const u32x4*)(stg+row*64+ch*8); ATTN_STORE16(Ow+(long)row*DM+ch*8,v);} }
  asm volatile("s_waitcnt lgkmcnt(0)\n\ts_barrier":::"memory");
  #undef DMA_K
  #undef DMA_V
  #undef CMASK
  #undef START
  #undef RESC
  #undef ROT
}

__device__ __forceinline__ void pv4(f32x16*o,lds_cptr vp,bf16x8 pa0,bf16x8 pa1,bf16x8 pa2,bf16x8 pa3){
  #pragma unroll
  for(int d0=0;d0<4;++d0){
    s16x4 lo[4],hi[4];
    #pragma unroll
    for(int ks=0;ks<4;++ks){ lo[ks]=vtr(vp+(d0*4096+ks*1024)); hi[ks]=vtr(vp+(d0*4096+ks*1024+512)); }
    #define PKF(k) (bf16x8){lo[k][0],lo[k][1],lo[k][2],lo[k][3],hi[k][0],hi[k][1],hi[k][2],hi[k][3]}
    o[d0]=__builtin_amdgcn_mfma_f32_32x32x16_bf16(pa0,PKF(0),o[d0],0,0,0);
    o[d0]=__builtin_amdgcn_mfma_f32_32x32x16_bf16(pa1,PKF(1),o[d0],0,0,0);
    o[d0]=__builtin_amdgcn_mfma_f32_32x32x16_bf16(pa2,PKF(2),o[d0],0,0,0);
    o[d0]=__builtin_amdgcn_mfma_f32_32x32x16_bf16(pa3,PKF(3),o[d0],0,0,0);
    #undef PKF
  }
}
__device__ __forceinline__ float rowmax_c(const f32x16&p0,const f32x16&p1){
  float a=__builtin_fmaxf(__builtin_fmaxf(p0[0],p0[1]),p1[0]),b=__builtin_fmaxf(__builtin_fmaxf(p0[2],p0[3]),p1[1]); a=__builtin_fmaxf(__builtin_fmaxf(a,p1[2]),p1[3]);
  #pragma unroll
  for(int r=4;r<16;r+=4){a=__builtin_fmaxf(__builtin_fmaxf(a,p0[r]),p0[r+1]);b=__builtin_fmaxf(__builtin_fmaxf(b,p0[r+2]),p0[r+3]);a=__builtin_fmaxf(__builtin_fmaxf(a,p1[r]),p1[r+1]);b=__builtin_fmaxf(__builtin_fmaxf(b,p1[r+2]),p1[r+3]);}
  float rm=__builtin_fmaxf(a,b);
  auto rr=__builtin_amdgcn_permlane32_swap(__float_as_uint(rm),__float_as_uint(rm),false,false);
  return __builtin_fmaxf(__uint_as_float(rr[0]),__uint_as_float(rr[1]));
}
constexpr int A128_KS=8192, A128_VS=16384, A128_NS=3, A128_NV=4;
constexpr int A128_K=0, A128_V=A128_NS*A128_KS, A128_WS=A128_V+A128_NV*A128_VS, A128_OST=A128_WS+NW*64*4, A128_BYTES=A128_OST+NW*4096;
template<int THRL> __device__ __forceinline__ void attn128_unit(int b,int qcol,int vcol,int qb,const bf16*Q,const bf16*__restrict__ K,const bf16*__restrict__ V,bf16*O,char*shm){
  const int tid=mk_tid(),lane=tid&63,r32=lane&31,hi=lane>>5; const int wid=__builtin_amdgcn_readfirstlane(tid>>6);
  const long rowbase=(long)b*SEQ; const int q0=qb*QB;
  const bf16*Qw=Q+(rowbase+q0+wid*QBLK)*DM+qcol;
  const bf16*Kh=K+rowbase*DM+qcol,*Vh=V+rowbase*DM+vcol;
  const unsigned lds0=(unsigned)(uintptr_t)shm;
  float*wsf=(float*)(shm+A128_WS)+wid*64;
  const bf16*ksrc=Kh+(long)lane*DM+wid*8;
  const bf16*vsrc=Vh+(long)(16*(wid&3)+(lane>>2))*DM+(wid>>2)*32+(lane&3)*8;
  const unsigned kdst=lds0+A128_K+wid*1024, vdst=lds0+A128_V+wid*1024;
  #define DMA_T(t,sl,sv) do{ glds16(ksrc+(long)(t)*KVBLK*DM,(unsigned)__builtin_amdgcn_readfirstlane(kdst+(sl)*A128_KS)); \
      glds16(vsrc+(long)(t)*KVBLK*DM,(unsigned)__builtin_amdgcn_readfirstlane(vdst+(sv)*A128_VS)); \
      glds16(vsrc+(long)(t)*KVBLK*DM+64,(unsigned)__builtin_amdgcn_readfirstlane(vdst+(sv)*A128_VS+8192)); }while(0)
  const lds_cptr vb0=(lds_cptr)shm+A128_V+((lane>>4)&1)*32+(lane&3)*8+(4*hi+((lane&15)>>2))*64;
  const int NT=(q0+QB)/KVBLK;
  bf16x8 qr[4];
  #pragma unroll
  for(int d0=0;d0<4;++d0)qr[d0]=*reinterpret_cast<const bf16x8*>(&Qw[(long)r32*DM+d0*16+hi*8]);
  DMA_T(0,0,0); DMA_T(1,1,1);
  const bool skew=(wid>=4);
  u32x4 pw0={0u,0u,0u,0u},pw1=pw0,pw2=pw0,pw3=pw0;
  float mhat=0.f,l_reg=0.f; f32x16 o[4]; o[0]=f32x16{};o[1]=f32x16{};o[2]=f32x16{};o[3]=f32x16{}; f32x16 negm=f32x16{};
  const int qrel=wid*QBLK+r32;
  int sl=0,sv=0;
  for(int t=0;t<NT;++t){
    if(t+1<NT){WAIT_BAR(3);}else{WAIT_BAR(0);}
    if(t+2<NT){const int s2=(sl==0)?2:sl-1; DMA_T(t+2,s2,(sv+2)&3);}
    if(skew&&t>0) pv4(o,vb0+((sv+3)&3)*A128_VS,__builtin_bit_cast(bf16x8,pw0),__builtin_bit_cast(bf16x8,pw1),__builtin_bit_cast(bf16x8,pw2),__builtin_bit_cast(bf16x8,pw3));
    f32x16 p0,p1;
    qkt(p0,p1,shm+A128_K+sl*A128_KS,qr,negm,r32,hi);
    { const int jb_=t-(NT-4); if(jb_>=0)cmask(p0,p1,jb_,qrel,hi); }
    const float rm=rowmax_c(p0,p1);
    bool resc=false;
    if(t==0){ const float dl=rm; mhat+=dl;
      #pragma unroll
      for(int r=0;r<16;++r){p0[r]-=dl;p1[r]-=dl;}
      #pragma unroll
      for(int r=0;r<16;++r)negm[r]=-mhat; }
    else if(__any(rm>(float)THRL)){ const float dl=__builtin_fmaxf(rm,0.f); mhat+=dl;
      #pragma unroll
      for(int r=0;r<16;++r){p0[r]-=dl;p1[r]-=dl;}
      #pragma unroll
      for(int r=0;r<16;++r)negm[r]=-mhat;
      const float f=__builtin_amdgcn_exp2f(-dl); l_reg*=f; if(hi==0)wsf[r32]=f; resc=true; }
    if(resc){ asm volatile("s_waitcnt lgkmcnt(0)":::"memory");
      #pragma unroll
      for(int d_=0;d_<4;++d_)
        #pragma unroll
        for(int r=0;r<16;++r)o[d_][r]*=wsf[crow(r,hi)]; }
    float sacc=0.f;
    #pragma unroll
    for(int r=0;r<16;++r){p0[r]=__builtin_amdgcn_exp2f(p0[r]);p1[r]=__builtin_amdgcn_exp2f(p1[r]);sacc+=p0[r]+p1[r];}
    l_reg+=sacc;
    pw0=(u32x4){cvtpk_s(p0[0],p0[1]),cvtpk_s(p0[2],p0[3]),cvtpk_s(p0[4],p0[5]),cvtpk_s(p0[6],p0[7])}; pw1=(u32x4){cvtpk_s(p0[8],p0[9]),cvtpk_s(p0[10],p0[11]),cvtpk_s(p0[12],p0[13]),cvtpk_s(p0[14],p0[15])};
    pw2=(u32x4){cvtpk_s(p1[0],p1[1]),cvtpk_s(p1[2],p1[3]),cvtpk_s(p1[4],p1[5]),cvtpk_s(p1[6],p1[7])}; pw3=(u32x4){cvtpk_s(p1[8],p1[9]),cvtpk_s(p1[10],p1[11]),cvtpk_s(p1[12],p1[13]),cvtpk_s(p1[14],p1[15])};
    if(!skew) pv4(o,vb0+sv*A128_VS,__builtin_bit_cast(bf16x8,pw0),__builtin_bit_cast(bf16x8,pw1),__builtin_bit_cast(bf16x8,pw2),__builtin_bit_cast(bf16x8,pw3));
    sl=(sl==2)?0:sl+1; sv=(sv+1)&3;
  }
  if(skew) pv4(o,vb0+((sv+3)&3)*A128_VS,__builtin_bit_cast(bf16x8,pw0),__builtin_bit_cast(bf16x8,pw1),__builtin_bit_cast(bf16x8,pw2),__builtin_bit_cast(bf16x8,pw3));
  {auto rr=__builtin_amdgcn_permlane32_swap(__float_as_uint(l_reg),__float_as_uint(l_reg),false,false);l_reg=__uint_as_float(rr[0])+__uint_as_float(rr[1]);}
  if(hi==0)wsf[32+r32]=l_reg;asm volatile("s_waitcnt lgkmcnt(0)":::"memory");
  float rli[16];
  #pragma unroll
  for(int r=0;r<16;++r)rli[r]=__builtin_amdgcn_rcpf(wsf[32+crow(r,hi)]);
  bf16*Ow=O+(rowbase+q0+wid*QBLK)*DM+vcol;
  _Float16*stg=(_Float16*)(shm+A128_OST)+wid*2048;
  #pragma unroll
  for(int dh=0;dh<2;++dh){
    #pragma unroll
    for(int r=0;r<16;++r){const int orow=crow(r,hi);
      #pragma unroll
      for(int d0=0;d0<2;++d0)stg[orow*64+d0*32+r32]=(_Float16)(o[dh*2+d0][r]*rli[r]);}
    asm volatile("s_waitcnt lgkmcnt(0)":::"memory");
    #pragma unroll
    for(int i=0;i<4;++i){const int row=i*8+(lane>>3),ch=lane&7; const u32x4 v=*(const u32x4*)(stg+row*64+ch*8); ATTN_STORE16(Ow+(long)row*DM+dh*64+ch*8,v);}
    asm volatile("s_waitcnt lgkmcnt(0)":::"memory");
  }
  asm volatile("s_waitcnt lgkmcnt(0)\n\ts_barrier":::"memory");
  #undef DMA_T
}

constexpr int B128_KS=16384, B128_VS=32768;
constexpr int B128_K=0, B128_V=2*B128_KS, B128_WS=B128_V+2*B128_VS, B128_BYTES=B128_WS+NW*64*4;
static_assert(B128_BYTES<=131072,"attention scratch stays below the LDS control words");
template<int THRL> __device__ __forceinline__ void attn128x2_unit(int b,int qcol,int vcol,int qb,const bf16*Q,const bf16*__restrict__ K,const bf16*__restrict__ V,bf16*O,char*shm){
  const int tid=mk_tid(),lane=tid&63,r32=lane&31,hi=lane>>5; const int wid=__builtin_amdgcn_readfirstlane(tid>>6);
  const long rowbase=(long)b*SEQ; const int q0=qb*QB;
  const bf16*Qw=Q+(rowbase+q0+wid*QBLK)*DM+qcol;
  const bf16*Kh=K+rowbase*DM+qcol,*Vh=V+rowbase*DM+vcol;
  const unsigned lds0=(unsigned)(uintptr_t)shm;
  float*wsf=(float*)(shm+B128_WS)+wid*64;
  const bf16*ksrc=Kh+(long)lane*DM+wid*8;
  const bf16*vsrc=Vh+(long)(16*(wid&3)+(lane>>2))*DM+(wid>>2)*32+(lane&3)*8;
  const unsigned kdst=lds0+B128_K+wid*1024, vdst=lds0+B128_V+wid*1024;
  #define DMA_S(t,sl) do{ _Pragma("unroll") for(int u_=0;u_<2;++u_){ \
      glds16(ksrc+(long)(2*(t)+u_)*KVBLK*DM,(unsigned)__builtin_amdgcn_readfirstlane(kdst+(sl)*B128_KS+u_*8192)); \
      glds16(vsrc+(long)(2*(t)+u_)*KVBLK*DM,(unsigned)__builtin_amdgcn_readfirstlane(vdst+(sl)*B128_VS+u_*16384)); \
      glds16(vsrc+(long)(2*(t)+u_)*KVBLK*DM+64,(unsigned)__builtin_amdgcn_readfirstlane(vdst+(sl)*B128_VS+u_*16384+8192)); } }while(0)
  const lds_cptr vb0=(lds_cptr)shm+B128_V+((lane>>4)&1)*32+(lane&3)*8+(4*hi+((lane&15)>>2))*64;
  const int NS=(q0+QB)/(2*KVBLK);
  bf16x8 qr[4];
  #pragma unroll
  for(int d0=0;d0<4;++d0)qr[d0]=*reinterpret_cast<const bf16x8*>(&Qw[(long)r32*DM+d0*16+hi*8]);
  DMA_S(0,0);
  float mhat=0.f,l_reg=0.f; f32x16 o[4]; o[0]=f32x16{};o[1]=f32x16{};o[2]=f32x16{};o[3]=f32x16{}; f32x16 negm=f32x16{};
  const int qrel=wid*QBLK+r32;
  for(int t=0;t<NS;++t){
    const int sl=t&1;
    WAIT_BAR(0);
    if(t+1<NS) DMA_S(t+1,sl^1);
    f32x16 a0,a1,b0,b1;
    qkt(a0,a1,shm+B128_K+sl*B128_KS,qr,negm,r32,hi);
    qkt(b0,b1,shm+B128_K+sl*B128_KS+8192,qr,negm,r32,hi);
    { const int jb_=2*(t-(NS-2)); if(jb_>=0){ cmask(a0,a1,jb_,qrel,hi); cmask(b0,b1,jb_+1,qrel,hi); } }
    const float rm=__builtin_fmaxf(rowmax_c(a0,a1),rowmax_c(b0,b1));
    bool resc=false;
    if(t==0){ const float dl=rm; mhat+=dl;
      #pragma unroll
      for(int r=0;r<16;++r){a0[r]-=dl;a1[r]-=dl;b0[r]-=dl;b1[r]-=dl;}
      #pragma unroll
      for(int r=0;r<16;++r)negm[r]=-mhat; }
    else if(__any(rm>(float)THRL)){ const float dl=__builtin_fmaxf(rm,0.f); mhat+=dl;
      #pragma unroll
      for(int r=0;r<16;++r){a0[r]-=dl;a1[r]-=dl;b0[r]-=dl;b1[r]-=dl;}
      #pragma unroll
      for(int r=0;r<16;++r)negm[r]=-mhat;
      const float f=__builtin_amdgcn_exp2f(-dl); l_reg*=f; if(hi==0)wsf[r32]=f; resc=true; }
    if(resc){ asm volatile("s_waitcnt lgkmcnt(0)":::"memory");
      #pragma unroll
      for(int d_=0;d_<4;++d_)
        #pragma unroll
        for(int r=0;r<16;++r)o[d_][r]*=wsf[crow(r,hi)]; }
    float sacc=0.f,sacc2=0.f;
    #pragma unroll
    for(int r=0;r<16;++r){a0[r]=__builtin_amdgcn_exp2f(a0[r]);a1[r]=__builtin_amdgcn_exp2f(a1[r]);sacc+=a0[r]+a1[r];}
    #pragma unroll
    for(int r=0;r<16;++r){b0[r]=__builtin_amdgcn_exp2f(b0[r]);b1[r]=__builtin_amdgcn_exp2f(b1[r]);sacc2+=b0[r]+b1[r];}
    l_reg+=sacc+sacc2;
    #define PW4(P,B) (u32x4){cvtpk_s(P[B],P[B+1]),cvtpk_s(P[B+2],P[B+3]),cvtpk_s(P[B+4],P[B+5]),cvtpk_s(P[B+6],P[B+7])}
    { const u32x4 w0=PW4(a0,0),w1=PW4(a0,8),w2=PW4(a1,0),w3=PW4(a1,8);
      pv4(o,vb0+sl*B128_VS,__builtin_bit_cast(bf16x8,w0),__builtin_bit_cast(bf16x8,w1),__builtin_bit_cast(bf16x8,w2),__builtin_bit_cast(bf16x8,w3)); }
    { const u32x4 w0=PW4(b0,0),w1=PW4(b0,8),w2=PW4(b1,0),w3=PW4(b1,8);
      pv4(o,vb0+sl*B128_VS+16384,__builtin_bit_cast(bf16x8,w0),__builtin_bit_cast(bf16x8,w1),__builtin_bit_cast(bf16x8,w2),__builtin_bit_cast(bf16x8,w3)); }
    #undef PW4
  }
  {auto rr=__builtin_amdgcn_permlane32_swap(__float_as_uint(l_reg),__float_as_uint(l_reg),false,false);l_reg=__uint_as_float(rr[0])+__uint_as_float(rr[1]);}
  if(hi==0)wsf[32+r32]=l_reg;asm volatile("s_waitcnt lgkmcnt(0)":::"memory");
  float rli[16];
  #pragma unroll
  for(int r=0;r<16;++r)rli[r]=__builtin_amdgcn_rcpf(wsf[32+crow(r,hi)]);
  bf16*Ow=O+(rowbase+q0+wid*QBLK)*DM+vcol;
  _Float16*stg=(_Float16*)(shm+B128_V+(NS&1)*B128_VS)+wid*2048;
  #pragma unroll
  for(int dh=0;dh<2;++dh){
    #pragma unroll
    for(int r=0;r<16;++r){const int orow=crow(r,hi);
      #pragma unroll
      for(int d0=0;d0<2;++d0)stg[orow*64+d0*32+r32]=(_Float16)(o[dh*2+d0][r]*rli[r]);}
    asm volatile("s_waitcnt lgkmcnt(0)":::"memory");
    #pragma unroll
    for(int i=0;i<4;++i){const int row=i*8+(lane>>3),ch=lane&7; const u32x4 v=*(const u32x4*)(stg+row*64+ch*8); ATTN_STORE16(Ow+(long)row*DM+dh*64+ch*8,v);}
    asm volatile("s_waitcnt lgkmcnt(0)":::"memory");
  }
  asm volatile("s_waitcnt lgkmcnt(0)\n\ts_barrier":::"memory");
  #undef DMA_S
}
#undef SBAR
#undef WAIT_BAR
}
#define LAS __attribute__((address_space(3)))
typedef unsigned short bf16;
typedef unsigned v4u __attribute__((ext_vector_type(4)));
typedef unsigned v2u __attribute__((ext_vector_type(2)));
typedef float f32x4 __attribute__((ext_vector_type(4)));
typedef float f32x16 __attribute__((ext_vector_type(16)));
typedef short bf16x8 __attribute__((ext_vector_type(8)));
typedef short s16x4 __attribute__((ext_vector_type(4)));
typedef _Float16 h16x2 __attribute__((ext_vector_type(2)));

constexpr int NWAVES = 8, NTHR = 512;
constexpr int BATCH = 16, SEQ = 4096, D = 1024, FF = 2816, TOK = BATCH * SEQ;
constexpr int LDS_BYTES = 147456;
constexpr size_t MiB = 1u << 20;
constexpr size_t WS_LB = 0;
constexpr size_t WS_BAR = 65536, BAR_BYTES = 16384;
constexpr int LDS_MISC = 131072;
constexpr size_t WS_RS = 262144;
constexpr size_t WS_CS = 1 * MiB;
constexpr size_t WS_SS = 17 * MiB;
constexpr size_t SS_SLOT = (size_t)TOK * 16;
constexpr size_t WS_W = 25 * MiB;
constexpr size_t WS_XN = 128 * MiB;
constexpr size_t WS_P = 256 * MiB;
constexpr size_t WS_O0 = 768 * MiB, WS_O1 = 896 * MiB;
constexpr size_t WS_END = 1024 * MiB;
constexpr size_t W_AIN = 0, W_AOUT = W_AIN + 2ull * 3072 * 1024, W_HIN = W_AOUT + 2ull * 1024 * 1024, W_HOUT = W_HIN + 2ull * 4096 * 1024,
                 W_FIN = W_HOUT + 2ull * 1024 * 1024, W_FOUT = W_FIN + 4ull * 5632 * 1024, W_ENDE = W_FOUT + 4ull * 1024 * 2816;
static_assert(WS_W + W_ENDE * 2 <= WS_XN, "weights fit");

__device__ const double INVF[32] = {1.0, 0.7498942093324559, 0.5623413251903491, 0.4216965034285822, 0.31622776601683794, 0.23713737056616552, 0.1778279410038923, 0.1333521432163324, 0.1, 0.07498942093324558, 0.05623413251903491, 0.042169650342858224, 0.03162277660168379, 0.023713737056616554, 0.01778279410038923, 0.01333521432163324, 0.01, 0.007498942093324558, 0.005623413251903491, 0.004216965034285823, 0.0031622776601683794, 0.0023713737056616554, 0.0017782794100389228, 0.001333521432163324, 0.001, 0.0007498942093324559, 0.0005623413251903491, 0.00042169650342858224, 0.00031622776601683794, 0.00023713737056616554, 0.00017782794100389227, 0.0001333521432163324};

struct Params { const float* in[18]; float* out; unsigned char* ws; int ph_lo, ph_hi; };

#define LBAR() asm volatile("s_waitcnt lgkmcnt(0)\n\ts_barrier" ::: "memory")
typedef float f32x2_c __attribute__((ext_vector_type(2))); typedef __bf16 bf16x2_c __attribute__((ext_vector_type(2)));
__device__ __forceinline__ unsigned pk2(float lo, float hi) { f32x2_c v = {lo, hi}; bf16x2_c b = __builtin_convertvector(v, bf16x2_c); return __builtin_bit_cast(unsigned, b); }
__device__ __forceinline__ unsigned f2bf(float f) { return pk2(f, 0.f) & 0xffffu; }
__device__ __forceinline__ float bf_lo(unsigned w) { return __builtin_bit_cast(float, w << 16); }
__device__ __forceinline__ float bf_hi(unsigned w) { return __builtin_bit_cast(float, w & 0xffff0000u); }
__device__ __forceinline__ float h_lo(unsigned w) { h16x2 v = __builtin_bit_cast(h16x2, w); return (float)v[0]; }
__device__ __forceinline__ float h_hi(unsigned w) { h16x2 v = __builtin_bit_cast(h16x2, w); return (float)v[1]; }
__device__ __forceinline__ int crow(int r, int hi) { return (r & 3) + 8 * (r >> 2) + 4 * hi; }

#define XB_TMO      128
#define XB_XCNT(j)  (256  + 64 * (j))
#define XB_XSUB(j)  (1280 + 64 * (j))
#define XB_XGEN(j)  (2304 + 64 * (j))
#define XB_TOP      3328
#define XB_TOPGEN   3392
#define XCD_BAR_WORDS 3456
#define XB_SPIN_CAP (1u << 18)

__device__ __forceinline__ unsigned xb_ld(unsigned* p)              { return __hip_atomic_load(p, __ATOMIC_RELAXED, __HIP_MEMORY_SCOPE_AGENT); }
__device__ __forceinline__ unsigned xb_add(unsigned* p, unsigned v) { return __hip_atomic_fetch_add(p, v, __ATOMIC_RELAXED, __HIP_MEMORY_SCOPE_AGENT); }
__device__ __forceinline__ unsigned xb_xcc_id() { return (unsigned)__builtin_amdgcn_s_getreg((3 << 11) | 20) & 0xFu; }
#define XB_SPIN(cond, bar) do { unsigned _sp = 0; while (cond) { __builtin_amdgcn_s_sleep(1); \
    if ((++_sp & 255u) == 0u) { if (xb_ld(&(bar)[XB_TMO])) break; if (_sp > XB_SPIN_CAP) { atomicAdd(&(bar)[XB_TMO], 1u); break; } } } } while (0)

struct XcdBarrier {
    unsigned* bar; unsigned x;
    volatile LAS unsigned* st;
};

__device__ __forceinline__ XcdBarrier xcd_barrier_post(unsigned* bar, volatile LAS unsigned* st) {
    XcdBarrier b; b.bar = bar; b.x = xb_xcc_id(); b.st = st;
    if (threadIdx.x == 0) (void)xb_add(&bar[XB_XCNT(b.x)], 1u);
    return b;
}
__device__ __forceinline__ void xcd_barrier_complete(unsigned* bar, unsigned x, unsigned& nloc, unsigned& nx) {
    const unsigned G = gridDim.x * gridDim.y * gridDim.z;
    unsigned sum, cnt, mine, sp = 0u;
    for (;;) {
        sum = 0u; cnt = 0u; mine = 0u;
#pragma unroll
        for (unsigned j = 0; j < 16; ++j) { const unsigned c = xb_ld(&bar[XB_XCNT(j)]); sum += c; cnt += (c > 0u) ? 1u : 0u; mine = (j == x) ? c : mine; }
        if (sum == G) break;
        __builtin_amdgcn_s_sleep(1);
        if ((++sp & 255u) == 0u) { if (xb_ld(&bar[XB_TMO])) break; if (sp > XB_SPIN_CAP) { atomicAdd(&bar[XB_TMO], 1u); break; } }
    }
    nloc = mine > 0u ? mine : 1u; nx = cnt > 0u ? cnt : 1u;
}

__device__ __forceinline__ void xcd_barrier(const XcdBarrier& b) {
    asm volatile("s_waitcnt vmcnt(0)" ::: "memory");
    __syncthreads();
    if (threadIdx.x == 0) {
        unsigned* bar = b.bar;
        __builtin_amdgcn_s_waitcnt(0);
        unsigned nloc = b.st[0], nx = b.st[1];
        if (nloc == 0u) { xcd_barrier_complete(bar, b.x, nloc, nx); b.st[0] = nloc; b.st[1] = nx; }
        const unsigned old = xb_add(&bar[XB_XSUB(b.x)], 1u);
        const unsigned gen = old / nloc;
        if (old + 1u == (gen + 1u) * nloc) {
            __builtin_amdgcn_fence(__ATOMIC_RELEASE, "agent");
            asm volatile("s_waitcnt vmcnt(0)" ::: "memory");
            const unsigned og = xb_add(&bar[XB_TOP], 1u);
            const unsigned tg = og / nx;
            if (og + 1u == (tg + 1u) * nx) xb_add(&bar[XB_TOPGEN], 1u);
            else XB_SPIN(xb_ld(&bar[XB_TOPGEN]) == tg, bar);
            __builtin_amdgcn_fence(__ATOMIC_ACQUIRE, "agent");
            xb_add(&bar[XB_XGEN(b.x)], 1u);
            asm volatile("s_waitcnt vmcnt(0)" ::: "memory");
        } else {
            XB_SPIN(xb_ld(&bar[XB_XGEN(b.x)]) == gen, bar);
            __builtin_amdgcn_fence(__ATOMIC_ACQUIRE, "agent");
            asm volatile("s_waitcnt vmcnt(0)" ::: "memory");
        }
    }
    __syncthreads();
}

__device__ __forceinline__ int srccol(int mode, int vc) {
    if (mode == 1) { if (vc < 2048) { const int w = vc & 63; return (vc & ~63) + (w >> 1) + 32 * (w & 1); } return vc; }
    if (mode == 2) return (vc & 1) * FF + (vc >> 1);
    return vc;
}
__device__ __forceinline__ void conv_matrix(const float* W, int K, int N, bf16* WT, int mode, const float* nw, LAS float* scr, int gw, int ngw, int lane) {
    const int nblk = N / 32, nitems = (K / 64) * nblk;
    const int c4 = lane & 7, kr = lane >> 3;
    for (int item = gw; item < nitems; item += ngw) {
        const int kb = item / nblk, nb = item % nblk, k0 = 64 * kb, n0 = 32 * nb;
        const bool inter = (mode == 2) || (mode == 1 && n0 < 2048);
        int sc, vl0, vst;
        if (inter) { const int e = c4 >> 2, i0 = 4 * (c4 & 3);
            sc = (mode == 2) ? e * FF + (n0 >> 1) + i0 : (n0 & ~63) + ((n0 & 63) >> 1) + 32 * e + i0;
            vl0 = 2 * i0 + e; vst = 2; }
        else { sc = n0 + 4 * c4; vl0 = 4 * c4; vst = 1; }
#pragma unroll
        for (int i = 0; i < 8; ++i) { const int kk = kr + 8 * i; f32x4 v = *(const f32x4*)(W + (size_t)(k0 + kk) * N + sc); if (nw) v = v * nw[k0 + kk];
            LAS float* d = scr + kk * 33 + vl0; d[0] = v.x; d[vst] = v.y; d[2 * vst] = v.z; d[3 * vst] = v.w; }
        asm volatile("s_waitcnt lgkmcnt(0)" ::: "memory");
        const int c = lane & 7;
#pragma unroll
        for (int j = 0; j < 4; ++j) { const int n = (lane >> 3) + 8 * j; const LAS float* s = scr + (8 * c) * 33 + n;
            v4u o; o.x = pk2(s[0 * 33], s[1 * 33]); o.y = pk2(s[2 * 33], s[3 * 33]); o.z = pk2(s[4 * 33], s[5 * 33]); o.w = pk2(s[6 * 33], s[7 * 33]);
            *(v4u*)(WT + (size_t)(n0 + n) * K + k0 + 8 * c) = o; }
        asm volatile("s_waitcnt lgkmcnt(0)" ::: "memory");
    }
}
__device__ __forceinline__ float wave_sum(float v) {
#pragma unroll
    for (int o = 1; o < 64; o <<= 1) v += __shfl_xor(v, o);
    return v;
}
__device__ __forceinline__ void p0_prologue(const Params& p, LAS unsigned char* lds, int vcu, int G) {
    const int tid = mk_tid(), lane = tid & 63, wave = __builtin_amdgcn_readfirstlane(tid >> 6);
    LAS float* scr = (LAS float*)(lds + wave * 16384);
    const int gw = vcu * NWAVES + wave, ngw = G * NWAVES;
    unsigned char* ws = p.ws;
    bf16* WB = (bf16*)(ws + WS_W);
    for (int j = 0; j < 2; ++j) {
        conv_matrix(p.in[5] + (size_t)j * D * 3 * D, D, 3 * D, WB + W_AIN + (size_t)j * 3 * D * D, 1, p.in[2] + (2 * j) * D, scr, gw, ngw, lane);
        conv_matrix(p.in[6] + (size_t)j * D * D, D, D, WB + W_AOUT + (size_t)j * D * D, 0, nullptr, scr, gw, ngw, lane);
        conv_matrix(p.in[12] + (size_t)j * D * 4 * D, D, 4 * D, WB + W_HIN + (size_t)j * 4 * D * D, 0, p.in[2] + (2 * j + 1) * D, scr, gw, ngw, lane);
        conv_matrix(p.in[13] + (size_t)j * D * D, D, D, WB + W_HOUT + (size_t)j * D * D, 0, nullptr, scr, gw, ngw, lane);
    }
    for (int l = 0; l < 4; ++l) {
        conv_matrix(p.in[16] + (size_t)l * D * 2 * FF, D, 2 * FF, WB + W_FIN + (size_t)l * 2 * FF * D, 2, p.in[3] + l * D, scr, gw, ngw, lane);
        conv_matrix(p.in[17] + (size_t)l * FF * D, FF, D, WB + W_FOUT + (size_t)l * D * FF, 0, nullptr, scr, gw, ngw, lane);
    }
    { const float* x = p.in[0]; bf16* XN = (bf16*)(ws + WS_XN); float* ss0 = (float*)(ws + WS_SS);
      for (int m = gw; m < TOK; m += ngw) {
          const f32x4* xr = (const f32x4*)(x + (size_t)m * D) + lane; f32x4 v[4]; float s = 0.f;
#pragma unroll
          for (int j = 0; j < 4; ++j) { v[j] = xr[64 * j]; s += (v[j].x * v[j].x + v[j].y * v[j].y) + (v[j].z * v[j].z + v[j].w * v[j].w); }
          s = wave_sum(s);
          v2u* o8 = (v2u*)(XN + (size_t)m * D) + lane;
#pragma unroll
          for (int j = 0; j < 4; ++j) { v2u w; w.x = pk2(v[j].x, v[j].y); w.y = pk2(v[j].z, v[j].w); o8[64 * j] = w; }
          if (lane < 16) ss0[(size_t)m * 16 + lane] = (lane == 0) ? s : 0.f;
      } }
    { const int* pos = (const int*)p.in[1]; float* cs = (float*)(ws + WS_CS); const int gt = vcu * NTHR + tid, ngt = G * NTHR;
      for (int idx = gt; idx < TOK * 32; idx += ngt) {
          const int t = idx >> 5, i = idx & 31;
          const double a = (double)pos[t] * INVF[i];
          const double k = __builtin_rint(a * 0.15915494309189535);
          double r = __builtin_fma(-k, 6.283185307179586, a); r = __builtin_fma(-k, 2.4492935982947064e-16, r);
          const float rf = (float)r;
          cs[2 * (size_t)idx] = cosf(rf); cs[2 * (size_t)idx + 1] = sinf(rf);
      } }
    if (vcu == 0) {
        float* LB = (float*)(ws + WS_LB);
        for (int c = tid; c < D; c += NTHR) {
            const float* lp = p.in[15]; const float a0 = lp[c], a1 = lp[D + c], a2 = lp[2 * D + c], a3 = lp[3 * D + c];
            const float mx = fmaxf(fmaxf(a0, a1), fmaxf(a2, a3));
            const float e0 = expf(a0 - mx), e1 = expf(a1 - mx), e2 = expf(a2 - mx), e3 = expf(a3 - mx), inv = 1.0f / (e0 + e1 + e2 + e3);
            LB[c] = e1 * inv; LB[D + c] = (e1 + e2 + e3) * inv;
        }
        if (wave == 0) {
            for (int j = 0; j < 2; ++j) {
                const float s1 = wave_sum(p.in[7][j * 64 + lane] * p.in[8][j * 64 + lane]), s2 = wave_sum(p.in[9][j * 64 + lane] * p.in[10][j * 64 + lane]);
                const float li = (j == 0) ? 0.2f : 0.47071301834358416f;
                if (lane == 0) LB[2 * D + j] = expf(s1) - expf(s2) + li;
            }
        }
    }
}

__device__ __forceinline__ void combine_phase(const unsigned short* O0, const unsigned short* O1, bf16* out, const float* subw, float lam, float post, int vcu, int G) {
    const int tid = mk_tid(), lane = tid & 63, gw = vcu * NWAVES + __builtin_amdgcn_readfirstlane(tid >> 6), ngw = G * NWAVES;
    f32x4 w4[4];
#pragma unroll
    for (int j = 0; j < 4; ++j) w4[j] = *(const f32x4*)(subw + ((16 * lane) & 127) + 4 * j);
    for (int m = gw; m < TOK; m += ngw) {
        const v4u* a = (const v4u*)(O0 + (size_t)m * D + 16 * lane); const v4u* b = (const v4u*)(O1 + (size_t)m * D + 16 * lane);
        const v4u a0 = a[0], a1 = a[1], b0 = b[0], b1 = b[1];
        float d[16];
#pragma unroll
        for (int j = 0; j < 4; ++j) { d[2 * j] = h_lo(a0[j]) - lam * h_lo(b0[j]); d[2 * j + 1] = h_hi(a0[j]) - lam * h_hi(b0[j]);
                                      d[8 + 2 * j] = h_lo(a1[j]) - lam * h_lo(b1[j]); d[9 + 2 * j] = h_hi(a1[j]) - lam * h_hi(b1[j]); }
        float s = 0.f;
#pragma unroll
        for (int j = 0; j < 16; ++j) s += d[j] * d[j];
        s += __shfl_xor(s, 1); s += __shfl_xor(s, 2); s += __shfl_xor(s, 4);
        const float rn = rsqrtf(s * (1.0f / 128.0f) + 1e-5f) * post;
        v4u o0, o1;
#pragma unroll
        for (int j = 0; j < 4; ++j) { o0[j] = pk2(d[2 * j] * rn * w4[j >> 1][2 * (j & 1)], d[2 * j + 1] * rn * w4[j >> 1][2 * (j & 1) + 1]);
                                      o1[j] = pk2(d[8 + 2 * j] * rn * w4[2 + (j >> 1)][2 * (j & 1)], d[9 + 2 * j] * rn * w4[2 + (j >> 1)][2 * (j & 1) + 1]); }
        v4u* op = (v4u*)(out + (size_t)m * D + 16 * lane); op[0] = o0; op[1] = o1;
    }
}
__device__ __forceinline__ void combine_block(const unsigned short* O0, const unsigned short* O1, bf16* out, const float* subw, float lam, float post, size_t row0, int col0) {
    const int tid = mk_tid(), lane = tid & 63, wid = __builtin_amdgcn_readfirstlane(tid >> 6);
    const int seg = lane & 7;
    f32x4 w4[4];
#pragma unroll
    for (int j = 0; j < 4; ++j) w4[j] = *(const f32x4*)(subw + 16 * seg + 4 * j);
#pragma unroll
    for (int step = 0; step < 4; ++step) {
        const size_t m = row0 + wid * 32 + step * 8 + (lane >> 3);
        const v4u* a = (const v4u*)(O0 + m * D + col0 + 16 * seg); const v4u* b = (const v4u*)(O1 + m * D + col0 + 16 * seg);
        const v4u a0 = a[0], a1 = a[1], b0 = b[0], b1 = b[1];
        float d[16];
#pragma unroll
        for (int j = 0; j < 4; ++j) { d[2 * j] = h_lo(a0[j]) - lam * h_lo(b0[j]); d[2 * j + 1] = h_hi(a0[j]) - lam * h_hi(b0[j]);
                                      d[8 + 2 * j] = h_lo(a1[j]) - lam * h_lo(b1[j]); d[9 + 2 * j] = h_hi(a1[j]) - lam * h_hi(b1[j]); }
        float s = 0.f;
#pragma unroll
        for (int j = 0; j < 16; ++j) s += d[j] * d[j];
        s += __shfl_xor(s, 1); s += __shfl_xor(s, 2); s += __shfl_xor(s, 4);
        const float rn = rsqrtf(s * (1.0f / 128.0f) + 1e-5f) * post;
        v4u o0, o1;
#pragma unroll
        for (int j = 0; j < 4; ++j) { o0[j] = pk2(d[2 * j] * rn * w4[j >> 1][2 * (j & 1)], d[2 * j + 1] * rn * w4[j >> 1][2 * (j & 1) + 1]);
                                      o1[j] = pk2(d[8 + 2 * j] * rn * w4[2 + (j >> 1)][2 * (j & 1)], d[9 + 2 * j] * rn * w4[2 + (j >> 1)][2 * (j & 1) + 1]); }
        v4u* op = (v4u*)(out + m * D + col0 + 16 * seg); op[0] = o0; op[1] = o1;
    }
}
__device__ __forceinline__ void gnorm_phase(bf16* O, const bf16* Gt, const float* gw_, int vcu, int G) {
    const int tid = mk_tid(), lane = tid & 63, gw = vcu * NWAVES + __builtin_amdgcn_readfirstlane(tid >> 6), ngw = G * NWAVES;
    f32x4 w4[4];
#pragma unroll
    for (int j = 0; j < 4; ++j) w4[j] = *(const f32x4*)(gw_ + ((16 * lane) & 127) + 4 * j);
    for (int m = gw; m < TOK; m += ngw) {
        v4u* a = (v4u*)(O + (size_t)m * D + 16 * lane); const v4u* b = (const v4u*)(Gt + (size_t)m * D + 16 * lane);
        const v4u a0 = a[0], a1 = a[1], b0 = b[0], b1 = b[1];
        float d[16], g[16];
#pragma unroll
        for (int j = 0; j < 4; ++j) { d[2 * j] = bf_lo(a0[j]); d[2 * j + 1] = bf_hi(a0[j]); d[8 + 2 * j] = bf_lo(a1[j]); d[9 + 2 * j] = bf_hi(a1[j]);
                                      g[2 * j] = bf_lo(b0[j]); g[2 * j + 1] = bf_hi(b0[j]); g[8 + 2 * j] = bf_lo(b1[j]); g[9 + 2 * j] = bf_hi(b1[j]); }
        float s = 0.f;
#pragma unroll
        for (int j = 0; j < 16; ++j) s += d[j] * d[j];
        s += __shfl_xor(s, 1); s += __shfl_xor(s, 2); s += __shfl_xor(s, 4);
        const float rn = rsqrtf(s * (1.0f / 128.0f) + 1e-6f);
        v4u o0, o1;
#pragma unroll
        for (int j = 0; j < 4; ++j) { o0[j] = pk2(d[2 * j] * rn * w4[j >> 1][2 * (j & 1)] * g[2 * j], d[2 * j + 1] * rn * w4[j >> 1][2 * (j & 1) + 1] * g[2 * j + 1]);
                                      o1[j] = pk2(d[8 + 2 * j] * rn * w4[2 + (j >> 1)][2 * (j & 1)] * g[8 + 2 * j], d[9 + 2 * j] * rn * w4[2 + (j >> 1)][2 * (j & 1) + 1] * g[9 + 2 * j]); }
        a[0] = o0; a[1] = o1;
    }
}
__device__ __forceinline__ void final_phase(const bf16* X, float* out, const float* ss, const float* fw, int vcu, int G) {
    const int tid = mk_tid(), lane = tid & 63, gw = vcu * NWAVES + __builtin_amdgcn_readfirstlane(tid >> 6), ngw = G * NWAVES;
    f32x4 w4[4];
#pragma unroll
    for (int j = 0; j < 4; ++j) w4[j] = *(const f32x4*)(fw + 16 * lane + 4 * j);
    for (int m = gw; m < TOK; m += ngw) {
        const float rs = pg8::row_rstd(ss, m, 1e-6f);
        const v4u* a = (const v4u*)(X + (size_t)m * D + 16 * lane); const v4u a0 = a[0], a1 = a[1];
        f32x4* op = (f32x4*)(out + (size_t)m * D + 16 * lane);
        op[0] = (f32x4){bf_lo(a0.x), bf_hi(a0.x), bf_lo(a0.y), bf_hi(a0.y)} * rs * w4[0];
        op[1] = (f32x4){bf_lo(a0.z), bf_hi(a0.z), bf_lo(a0.w), bf_hi(a0.w)} * rs * w4[1];
        op[2] = (f32x4){bf_lo(a1.x), bf_hi(a1.x), bf_lo(a1.y), bf_hi(a1.y)} * rs * w4[2];
        op[3] = (f32x4){bf_lo(a1.z), bf_hi(a1.z), bf_lo(a1.w), bf_hi(a1.w)} * rs * w4[3];
    }
}
constexpr int SC_QDT = 0, SC_KDT = 8192, SC_KET = 16384, SC_VT = 26624, SC_VTB = 5120, SC_DEC = 36864, SC_OP = 37376, SC_END = 53760;
constexpr int KTP = 40;
__device__ __forceinline__ void scan_item(LAS unsigned char* lds, const bf16* Pq, const unsigned short* Plf, const bf16* Pv, bf16* Oo, int item) {
    typedef __attribute__((address_space(3))) const char* lcp;
    const int tid = mk_tid(), lane = tid & 63, wid = __builtin_amdgcn_readfirstlane(tid >> 6);
    const int bh = item >> 1, vs = item & 1, b = bh >> 3, h = bh & 7;
    const size_t row0 = (size_t)b * SEQ;
    LAS unsigned short* QDT = (LAS unsigned short*)(lds + SC_QDT); LAS unsigned short* KDT = (LAS unsigned short*)(lds + SC_KDT);
    LAS unsigned short* KET = (LAS unsigned short*)(lds + SC_KET); LAS unsigned short* VT0 = (LAS unsigned short*)(lds + SC_VT);
    LAS float* DEC = (LAS float*)(lds + SC_DEC); LAS unsigned* OPH = (LAS unsigned*)(lds + SC_OP);
    const int ch = 16 * wid + (lane & 15), tg = lane >> 4;
    const int n32 = lane & 31, hi = lane >> 5, kb = wid >> 1, vb = wid & 1;
    const unsigned short* gq = (const unsigned short*)Pq + (row0 + tg * 8) * D + h * 128 + ch;
    const unsigned short* gl = Plf + (row0 + tg * 8) * D + h * 128 + ch;
    const int vtok = tid & 31, vcg = (tid >> 5) & 7;
    const v4u* gv = (const v4u*)(Pv + (row0 + vtok) * D + h * 128 + vs * 64 + vcg * 8);
    constexpr size_t CSTEP = (size_t)32 * D * 2 / 16, CEL = (size_t)32 * D;
    unsigned rq[8], rl[8]; v4u rv = (v4u){0u, 0u, 0u, 0u};
#pragma unroll
    for (int i = 0; i < 8; ++i) { rq[i] = gq[(size_t)i * D]; rl[i] = gl[(size_t)i * D]; }
    if (tid < 256) rv = gv[0];
    const int troff = ((lane >> 4) & 1) * 32 + (lane & 3) * 8 + (4 * hi + ((lane & 15) >> 2)) * 64;
    f32x16 st;
#pragma unroll
    for (int r = 0; r < 16; ++r) st[r] = 0.f;
    constexpr int NCH = SEQ / 32;
    const int otok = tid & 31, ovq = tid >> 5, ovbb = ovq >> 3, ovl0 = (ovq & 7) * 4;
    bf16* ogp = Oo + (row0 + otok) * D + h * 128 + vs * 64 + ovq * 4;
#define SC_STORE_O(nn) do { float o_[4]; _Pragma("unroll") for (int j = 0; j < 2; ++j) { const int a_ = ovbb * 512 + ((ovl0 >> 1) + j) * 32 + otok; const unsigned w0_ = OPH[a_], w1_ = OPH[a_ + 1024], w2_ = OPH[a_ + 2048], w3_ = OPH[a_ + 3072]; \
        o_[2 * j] = (bf_lo(w0_) + bf_lo(w1_)) + (bf_lo(w2_) + bf_lo(w3_)); o_[2 * j + 1] = (bf_hi(w0_) + bf_hi(w1_)) + (bf_hi(w2_) + bf_hi(w3_)); } \
        v2u w_; w_.x = pk2(o_[0], o_[1]); w_.y = pk2(o_[2], o_[3]); *(v2u*)(ogp + (size_t)(nn) * 32 * D) = w_; } while (0)
#define SC_TRF(base) ({ const s16x4 lo_ = attn_body::vtr((lcp)(base) + troff), hi_ = attn_body::vtr((lcp)(base) + troff + 512); (bf16x8){lo_[0], lo_[1], lo_[2], lo_[3], hi_[0], hi_[1], hi_[2], hi_[3]}; })
    for (int n = 0; n < NCH; ++n) {
        LAS unsigned short* VT = VT0 + (n & 1) * (SC_VTB / 2);
        {
            float f[8]; float tsum = 0.f;
#pragma unroll
            for (int i = 0; i < 8; ++i) { const float l = h_lo(rl[i]); tsum += l; f[i] = __expf(l); }
            const float t0 = __shfl(tsum, lane & 15), t1 = __shfl(tsum, (lane & 15) + 16), t2 = __shfl(tsum, (lane & 15) + 32), t3 = __shfl(tsum, (lane & 15) + 48);
            const float off = (tg > 0 ? t0 : 0.f) + (tg > 1 ? t1 : 0.f) + (tg > 2 ? t2 : 0.f);
            const float blast = (t0 + t1) + (t2 + t3);
            const float eb = __expf(blast);
            float e = __expf(off), qd[8], kd[8], ke[8];
#pragma unroll
            for (int i = 0; i < 8; ++i) {
                e *= f[i];
                const float inv = __builtin_amdgcn_rcpf(e);
                const float k = 1.0f - f[i];
                qd[i] = bf_lo(rq[i]) * e; kd[i] = k * inv; ke[i] = k * (eb * inv);
            }
            v4u w;
            w.x = pk2(qd[0], qd[1]); w.y = pk2(qd[2], qd[3]); w.z = pk2(qd[4], qd[5]); w.w = pk2(qd[6], qd[7]); *(LAS v4u*)(QDT + ch * 32 + tg * 8) = w;
            w.x = pk2(kd[0], kd[1]); w.y = pk2(kd[2], kd[3]); w.z = pk2(kd[4], kd[5]); w.w = pk2(kd[6], kd[7]); *(LAS v4u*)(KDT + ch * 32 + tg * 8) = w;
            w.x = pk2(ke[0], ke[1]); w.y = pk2(ke[2], ke[3]); w.z = pk2(ke[4], ke[5]); w.w = pk2(ke[6], ke[7]); *(LAS v4u*)(KET + ch * KTP + tg * 8) = w;
            if (tg == 0) DEC[ch] = eb;
        }
        if (tid < 256) {
#pragma unroll
            for (int j = 0; j < 4; ++j) { VT[(vcg * 8 + 2 * j) * KTP + vtok] = (unsigned short)(rv[j] & 0xffffu); VT[(vcg * 8 + 2 * j + 1) * KTP + vtok] = (unsigned short)(rv[j] >> 16); }
        }
        if (n + 1 < NCH) {
#pragma unroll
            for (int i = 0; i < 8; ++i) { rq[i] = gq[(size_t)(n + 1) * CEL + (size_t)i * D]; rl[i] = gl[(size_t)(n + 1) * CEL + (size_t)i * D]; }
            if (tid < 256) rv = gv[(size_t)(n + 1) * CSTEP];
        }
        if (n > 0) SC_STORE_O(n - 1);
        LBAR();
        {
            f32x16 sT;
#pragma unroll
            for (int r = 0; r < 16; ++r) sT[r] = 0.f;
#pragma unroll
            for (int s = 0; s < 2; ++s) {
                const bf16x8 a = SC_TRF(KDT + (kb * 2 + s) * 512);
                const bf16x8 bq = SC_TRF(QDT + (kb * 2 + s) * 512);
                sT = __builtin_amdgcn_mfma_f32_32x32x16_bf16(a, bq, sT, 0, 0, 0);
            }
#pragma unroll
            for (int r = 0; r < 16; ++r) { if (crow(r, hi) > n32) sT[r] = 0.f; }
            f32x16 oT;
#pragma unroll
            for (int r = 0; r < 16; ++r) oT[r] = 0.f;
#pragma unroll
            for (int s = 0; s < 2; ++s) {
                v4u bsw; bsw.x = pk2(sT[8 * s + 0], sT[8 * s + 1]); bsw.y = pk2(sT[8 * s + 2], sT[8 * s + 3]); bsw.z = pk2(sT[8 * s + 4], sT[8 * s + 5]); bsw.w = pk2(sT[8 * s + 6], sT[8 * s + 7]);
                const v2u vlo = *(const LAS v2u*)(VT + (vb * 32 + n32) * KTP + 16 * s + 4 * hi), vhi = *(const LAS v2u*)(VT + (vb * 32 + n32) * KTP + 16 * s + 8 + 4 * hi);
                const v4u avw = {vlo.x, vlo.y, vhi.x, vhi.y};
                oT = __builtin_amdgcn_mfma_f32_32x32x16_bf16(__builtin_bit_cast(bf16x8, avw), __builtin_bit_cast(bf16x8, bsw), oT, 0, 0, 0);
                v4u asw; asw.x = pk2(st[8 * s + 0], st[8 * s + 1]); asw.y = pk2(st[8 * s + 2], st[8 * s + 3]); asw.z = pk2(st[8 * s + 4], st[8 * s + 5]); asw.w = pk2(st[8 * s + 6], st[8 * s + 7]);
                const bf16x8 bqp = SC_TRF(QDT + (kb * 2 + s) * 512);
                oT = __builtin_amdgcn_mfma_f32_32x32x16_bf16(__builtin_bit_cast(bf16x8, asw), bqp, oT, 0, 0, 0);
            }
#pragma unroll
            for (int r = 0; r < 16; r += 2) OPH[wid * 512 + (crow(r, hi) >> 1) * 32 + n32] = pk2(oT[r], oT[r + 1]);
#pragma unroll
            for (int r = 0; r < 16; ++r) st[r] *= DEC[kb * 32 + crow(r, hi)];
#pragma unroll
            for (int s = 0; s < 2; ++s) {
                const bf16x8 a = *(const LAS bf16x8*)(KET + (kb * 32 + n32) * KTP + 16 * s + 8 * hi);
                const bf16x8 bv = *(const LAS bf16x8*)(VT + (vb * 32 + n32) * KTP + 16 * s + 8 * hi);
                st = __builtin_amdgcn_mfma_f32_32x32x16_bf16(a, bv, st, 0, 0, 0);
            }
        }
        LBAR();
    }
    SC_STORE_O(NCH - 1);
#undef SC_STORE_O
#undef SC_TRF
    LBAR();
}
constexpr int N_PHASES = 26;
__global__ void __launch_bounds__(NTHR, 2) mk_fwd(Params p) {
    extern __shared__ __attribute__((aligned(16))) unsigned char lds_raw[];
    cg::grid_group grid = cg::this_grid();
    LAS unsigned char* lds = (LAS unsigned char*)lds_raw;
    const int G = gridDim.x, bx = blockIdx.x;
    const int vcu = (G % 8 == 0) ? (bx % 8) * (G / 8) + bx / 8 : bx;
    unsigned char* ws = p.ws;
    bf16* WB = (bf16*)(ws + WS_W); bf16* XN = (bf16*)(ws + WS_XN); bf16* P0 = (bf16*)(ws + WS_P);
    bf16* O0 = (bf16*)(ws + WS_O0); bf16* O1 = (bf16*)(ws + WS_O1);
    float* SS = (float*)(ws + WS_SS); const float* LB = (const float*)(ws + WS_LB); const float* CS = (const float*)(ws + WS_CS);
    const int lo = p.ph_lo, hi = p.ph_hi;
#define IN(k) (lo <= (k) && (k) < hi)
#define SEAM(k) do { if (IN(k) && IN((k) + 1)) { if ((k) == 0) grid.sync(); else xcd_barrier(bar); } } while (0)
    { const int t0 = mk_tid(); if (t0 < 64) ((LAS unsigned*)(lds + LDS_MISC))[t0] = 0u; __syncthreads(); }
    XcdBarrier bar; bar.bar = (unsigned*)(ws + WS_BAR); bar.x = 0; bar.st = (volatile LAS unsigned*)(lds + LDS_MISC) + 8;
#if MK_MULTI
    bar = xcd_barrier_post((unsigned*)(ws + WS_BAR), (volatile LAS unsigned*)(lds + LDS_MISC) + 8);
#else
    if (bx == 0) { const int t0 = mk_tid(); for (int u = t0; u < (int)(BAR_BYTES / 4); u += NTHR) ((unsigned*)(ws + WS_BAR))[u] = 0u; }
#endif
#ifndef SKIP_P0
    if (IN(0)) p0_prologue(p, lds, vcu, G);
#endif
    SEAM(0);
#if !MK_MULTI
    bar = xcd_barrier_post((unsigned*)(ws + WS_BAR), (volatile LAS unsigned*)(lds + LDS_MISC) + 8);
#endif
    LAS unsigned char* RSL = lds + LDS_MISC + 256;
#define RS_PREPASS(S_) do { const int t_ = mk_tid(); pg8::Unit u_; int last_ = -1, ns_ = 0; for (int i_ = 0; (S_).next(i_, u_); ++i_) { if (u_.pm != last_) { last_ = u_.pm; \
        if (t_ < 256) ((LAS float*)(RSL + 256))[ns_ * 256 + t_] = pg8::row_rstd(ss_in, u_.pm * 256 + t_, 1e-6f); if (t_ == 0) RSL[u_.pm] = (unsigned char)ns_; ++ns_; } } \
        asm volatile("s_waitcnt vmcnt(0) lgkmcnt(0)" ::: "memory"); __syncthreads(); } while (0)
#pragma unroll 1
    for (int hl = 0; hl < 8; ++hl) {
        const int L = hl >> 1, pb = 1 + 6 * L, j = L >> 1;
        const float* ss_in = SS + (size_t)(hl & 1) * SS_SLOT; float* ss_out = SS + (size_t)((hl + 1) & 1) * SS_SLOT;
        const bf16* Aop; const bf16* Bop; int Kop, pg4;
        if ((hl & 1) == 0) {
            pg4 = pb + 3; Kop = D;
            if ((L & 1) == 0) {
                Aop = P0; Bop = WB + W_AOUT + (size_t)j * D * D;
#ifndef SKIP_G1
                if (IN(pb)) { pg8::Gemm g{XN, WB + W_AIN + (size_t)j * 3 * D * D, TOK, 3 * D, D}; pg8::StaticOrder S; S.init(TOK, 3 * D, G, bx);
                    RS_PREPASS(S); pg8::EpiQKV E{P0, RSL, CS};
                    pg8::gemm_phase<pg8::EpiQKV, pg8::StaticOrder, true, true>(lds, g, S, E); }
#endif
                SEAM(pb);
#ifndef SKIP_ATTN
                if (IN(pb + 1)) {
                    const attn_body::bf16* Q = (const attn_body::bf16*)P0; const attn_body::bf16* K = (const attn_body::bf16*)(P0 + pg8::TSTRIDE); const attn_body::bf16* V = (const attn_body::bf16*)(P0 + 2 * pg8::TSTRIDE);
#if MK_ATTN128
                    const int ngrp = G >> 3, grp = vcu >> 3, sq = vcu & 7, per = (BATCH * 16) / ngrp;
                    for (int it = 0; it < per; ++it) {
                        const int pu = grp * per + it, b = pu >> 4, uu = pu & 15, h = uu >> 1, c = uu & 1;
                        attn_body::bf16* O = (attn_body::bf16*)(c ? O1 : O0);
                        for (int half = 0; half < 2; ++half) {
                            const int qb = half ? sq : 15 - sq;
#if MK_ATTN_X2
                            attn_body::attn128x2_unit<8>(b, (h * 2 + c) * 64, h * 128, qb, Q, K, V, O, (char*)lds_raw);
#else
                            attn_body::attn128_unit<8>(b, (h * 2 + c) * 64, h * 128, qb, Q, K, V, O, (char*)lds_raw);
#endif
                        }
#if MK_FUSE_COMBINE
                        if (c == 1) {
                            asm volatile("s_waitcnt vmcnt(0)" ::: "memory"); __syncthreads();
                            for (int half = 0; half < 2; ++half)
                                combine_block((const unsigned short*)O0, (const unsigned short*)O1, P0, p.in[11] + j * 128, LB[2 * D + j], (j == 0) ? 0.8f : (1.0f - 0.47071301834358416f), (size_t)b * SEQ + (size_t)(half ? sq : 15 - sq) * 256, h * 128);
                        }
#endif
                    }
                }
#else
                    const int ngrp = G >> 3, grp = vcu >> 3, sq = vcu & 7, per = (BATCH * 32) / ngrp;
                    for (int it = 0; it < per; ++it) {
                        const int pu = grp * per + it, b = pu >> 5, uu = pu & 31, h = uu >> 2, c = (uu >> 1) & 1, vh = uu & 1;
                        attn_body::bf16* O = (attn_body::bf16*)(c ? O1 : O0);
                        for (int half = 0; half < 2; ++half) {
                            const int qb = half ? sq : 15 - sq;
                            attn_body::attn_unit<8>(b, (h * 2 + c) * 64, h * 128 + vh * 64, qb, Q, K, V, O, (char*)lds_raw);
                        }
                    }
                }
#endif
#endif
                SEAM(pb + 1);
#if !(MK_ATTN128 && MK_FUSE_COMBINE)
                if (IN(pb + 2)) combine_phase((const unsigned short*)O0, (const unsigned short*)O1, P0, p.in[11] + j * 128, LB[2 * D + j], (j == 0) ? 0.8f : (1.0f - 0.47071301834358416f), vcu, G);
                SEAM(pb + 2);
#endif
            } else {
                Aop = O0; Bop = WB + W_HOUT + (size_t)j * D * D;
#ifndef SKIP_G2
                if (IN(pb)) { pg8::Gemm g{XN, WB + W_HIN + (size_t)j * 4 * D * D, TOK, 4 * D, D}; pg8::StaticOrder S; S.init(TOK, 4 * D, G, bx);
                    RS_PREPASS(S); pg8::EpiHG E{P0, RSL, LB + j * D};
                    pg8::gemm_phase<pg8::EpiHG, pg8::StaticOrder, true, true>(lds, g, S, E); }
#endif
                SEAM(pb);
#ifndef SKIP_SCAN
                if (IN(pb + 1)) { for (int item = vcu; item < BATCH * 8 * 2; item += G) scan_item(lds, P0, (const unsigned short*)(P0 + pg8::TSTRIDE), P0 + 2 * pg8::TSTRIDE, O0, item); }
#endif
                SEAM(pb + 1);
                if (IN(pb + 2)) gnorm_phase(O0, P0 + 3 * pg8::TSTRIDE, p.in[14] + j * 128, vcu, G);
                SEAM(pb + 2);
            }
        } else {
            pg4 = pb + 5; Kop = FF; Aop = P0; Bop = WB + W_FOUT + (size_t)L * D * FF;
#ifndef SKIP_G3
            if (IN(pb + 4)) { pg8::Gemm g{XN, WB + W_FIN + (size_t)L * 2 * FF * D, TOK, 2 * FF, D}; pg8::StaticOrder S; S.init(TOK, 2 * FF, G, bx);
                RS_PREPASS(S); pg8::EpiFFN E{P0, RSL};
                pg8::gemm_phase<pg8::EpiFFN, pg8::StaticOrder, true, true>(lds, g, S, E); }
#endif
            SEAM(pb + 4);
        }
#ifndef SKIP_G4
        if (IN(pg4)) { pg8::Gemm g{Aop, Bop, TOK, D, Kop}; pg8::StaticOrder S; S.init(TOK, D, G, bx);
            pg8::EpiRes E{XN, ss_out};
            pg8::gemm_phase<pg8::EpiRes, pg8::StaticOrder, true, true>(lds, g, S, E); }
#endif
        SEAM(pg4);
    }
    if (IN(25)) final_phase(XN, p.out, SS, p.in[4], vcu, G);
#undef IN
#undef SEAM
}

extern "C" void kernel_launch(void* const* d_in, const int* in_sizes, int n_in, void* d_out, int out_size, void* d_ws, size_t ws_size, hipStream_t stream) {
    static int grid = 0;
    if (grid == 0) {
        if (n_in != 18 || out_size != TOK * D || ws_size < WS_END) { fprintf(stderr, "kernel_launch: unexpected shapes (n_in %d out %d ws %zu)\n", n_in, out_size, ws_size); grid = -1; return; }
        int dev = 0, cus = 0, per_cu = 0;
        hipGetDevice(&dev); hipDeviceGetAttribute(&cus, hipDeviceAttributeMultiprocessorCount, dev);
        if (hipFuncSetAttribute((const void*)mk_fwd, hipFuncAttributeMaxDynamicSharedMemorySize, LDS_BYTES) != hipSuccess) { fprintf(stderr, "kernel_launch: hipFuncSetAttribute failed\n"); grid = -1; return; }
        if (hipOccupancyMaxActiveBlocksPerMultiprocessor(&per_cu, (const void*)mk_fwd, NTHR, LDS_BYTES) != hipSuccess || per_cu < 1) { fprintf(stderr, "kernel_launch: occupancy query says %d\n", per_cu); per_cu = 1; }
        (void)hipGetLastError();
        grid = cus * 1;
        if (grid > 256) grid = 256;
    }
    if (grid < 0) return;
#if MK_MULTI
    (void)hipMemsetAsync((char*)d_ws + WS_BAR, 0, BAR_BYTES, stream);
#endif
    Params a{};
    for (int i = 0; i < 18; ++i) a.in[i] = (const float*)d_in[i];
    a.out = (float*)d_out; a.ws = (unsigned char*)d_ws;
#if MK_MULTI
    for (int ph = 0; ph < N_PHASES; ++ph) { a.ph_lo = ph; a.ph_hi = ph + 1; hipLaunchKernelGGL(mk_fwd, dim3(grid), dim3(NTHR), LDS_BYTES, stream, a); }
#else
    a.ph_lo = 0; a.ph_hi = N_PHASES;
    void* args[] = {&a};
    hipError_t e = hipLaunchCooperativeKernel((const void*)mk_fwd, dim3(grid), dim3(NTHR), args, LDS_BYTES, stream);
    if (e != hipSuccess) fprintf(stderr, "cooperative launch failed: %s (grid %d)\n", hipGetErrorString(e), grid);
#endif
}
```

```cpp
#include <hip/hip_runtime.h>
#include <hip/hip_bf16.h>
#include <hip/hip_cooperative_groups.h>
#include <cstdio>
#include <cstdint>
namespace cg = cooperative_groups;
#ifndef MK_ATTN128
#define MK_ATTN128 1
#endif
#ifndef MK_FUSE_COMBINE
#define MK_FUSE_COMBINE 1
#endif
#ifndef MK_ATTN_X2
#define MK_ATTN_X2 1
#endif
#ifndef MK_MULTI
#define MK_MULTI 0
#endif
__device__ __forceinline__ int mk_tid() { int t = threadIdx.x; asm volatile("" : "+v"(t)); return t; }
namespace pg8 {
#define PG8_LAS __attribute__((address_space(3)))
typedef unsigned short bf16_t;
typedef short bf16x8 __attribute__((ext_vector_type(8)));
typedef float f32x4 __attribute__((ext_vector_type(4)));
typedef unsigned u32x4 __attribute__((ext_vector_type(4)));
constexpr int BM = 256, BK = 64, HALF = 128, HTB = HALF * BK * 2  , STAGE_BYTES = 8 * HTB, NXCD = 8, WGM = 8;

__host__ __device__ __forceinline__ int lds_byte(int r, int c) { const int st = (r >> 4) * 2 + (c >> 5), rr = r & 15, cc = c & 31, ob = rr * 64 + cc * 2; return st * 1024 + (ob ^ (((ob >> 9) & 1) << 5)); }
__host__ __device__ __forceinline__ void stage_rc(int b, int& R, int& C) { const int st = b / 1024, sb = b % 1024, swz = sb ^ (((sb >> 9) & 1) << 5); R = (st >> 1) * 16 + swz / 64; C = (st & 1) * 32 + (swz % 64) / 2; }
__host__ __device__ __forceinline__ int perm32(int rho) { const int n = rho >> 4, i = rho & 15; return 8 * (i >> 2) + 4 * n + (i & 3); }

struct Unit { int pm, pn; };
struct Gemm { const bf16_t* A; const bf16_t* Bt; int M, N, K; };

struct StaticOrder {
    int nM, nN, nwg, G, c;
    __host__ __device__ void init(int M, int N, int G_, int c_) { nM = M / BM; nN = N / BM; nwg = nM * nN; G = G_; c = c_; }
    __host__ __device__ bool next(int i, Unit& u) const {
        const long L = (long)i * G + c; if (L >= nwg) return false;
        int wgid = (int)L; { const int q = nwg / NXCD, r = nwg % NXCD, xcd = wgid % NXCD, off = wgid / NXCD; wgid = (xcd < r ? xcd * (q + 1) : r * (q + 1) + (xcd - r) * q) + off; }
        const int nig = WGM * nN, gid = wgid / nig, fm = gid * WGM, gsz = (nM - fm) < WGM ? (nM - fm) : WGM;
        u.pm = fm + ((wgid % nig) % gsz); u.pn = (wgid % nig) / gsz; return true;
    }
    __device__ __forceinline__ void a_ready(const Unit&) const {}
    __device__ __forceinline__ void done(const Unit&) const {}
};
__device__ __forceinline__ unsigned cvt_pk_bf16(float lo, float hi) { unsigned r; asm volatile("v_cvt_pk_bf16_f32 %0, %1, %2" : "=v"(r) : "v"(lo), "v"(hi)); return r; }
}
namespace pg8 {
constexpr int TOK = 65536;
constexpr size_t TSTRIDE = (size_t)TOK * 1024;
constexpr float QK_C2 = 0.125f * 1.4426950408889634f;
typedef unsigned u32x2 __attribute__((ext_vector_type(2)));
typedef _Float16 h16x2 __attribute__((ext_vector_type(2)));
__device__ __forceinline__ unsigned pk_h2(float lo, float hi) { h16x2 v = {(_Float16)lo, (_Float16)hi}; return __builtin_bit_cast(unsigned, v); }
__device__ __forceinline__ float sigm(float x) { return __builtin_amdgcn_rcpf(1.0f + __expf(-x)); }
__device__ __forceinline__ float silu(float x) { return x * sigm(x); }
__device__ __forceinline__ float row_rstd(const float* ss, int row, float eps) { const f32x4* q = (const f32x4*)(ss + (size_t)row * 16); const f32x4 a = q[0], b = q[1], c = q[2], d = q[3];
    const f32x4 t = (a + b) + (c + d); return rsqrtf(((t[0] + t[1]) + (t[2] + t[3])) * (1.0f / 1024.0f) + eps); }

#define PG8_LOAD_RS(rs8, RS) do { const int sl_ = ((const PG8_LAS unsigned char*)(RS))[u.pm]; const PG8_LAS float* rt_ = (const PG8_LAS float*)((const PG8_LAS unsigned char*)(RS) + 256) + sl_ * 256; \
    _Pragma("unroll") for (int ai = 0; ai < 2; ++ai) _Pragma("unroll") for (int m = 0; m < 4; ++m) rs8[ai * 4 + m] = rt_[ai * HALF + wr * 64 + m * 16 + fr]; } while (0)
struct EpiQKV {
    static constexpr bool PERM = true, AFTER_DRAIN = false;
    bf16_t* P; const PG8_LAS unsigned char* ss; const float* cs;
    __device__ __forceinline__ void operator()(const f32x4 (&acc)[2][2][4][2], const Unit& u, int wr, int wc, int fr, int fq) const {
        const int colt = u.pn * BM, t = colt >> 10;
        bf16_t* base = P + (size_t)t * TSTRIDE;
        const int col0 = (colt & 1023) + wc * 32 + 8 * fq, i0 = (wc & 1) * 16 + 4 * fq;
        const float qs = (t == 0) ? QK_C2 : 1.0f;
        float rs8[8]; PG8_LOAD_RS(rs8, ss);
#pragma unroll
        for (int ai = 0; ai < 2; ++ai) {
            f32x4 c01a[4], c23a[4];
            if (t < 2) {
#pragma unroll
                for (int m = 0; m < 4; ++m) { const float* cp = cs + (size_t)(u.pm * BM + ai * HALF + wr * 64 + m * 16 + fr) * 64 + i0 * 2; c01a[m] = *(const f32x4*)cp; c23a[m] = *(const f32x4*)(cp + 4); }
            }
#pragma unroll
            for (int m = 0; m < 4; ++m) {
                const int row = u.pm * BM + ai * HALF + wr * 64 + m * 16 + fr;
                const float rs = rs8[ai * 4 + m];
                f32x4 c01 = {1.f, 0.f, 1.f, 0.f}, c23 = {1.f, 0.f, 1.f, 0.f};
                if (t < 2) { c01 = c01a[m]; c23 = c23a[m]; }
                bf16_t* rowp = base + (size_t)row * 1024 + col0;
#pragma unroll
                for (int bj = 0; bj < 2; ++bj) {
                    f32x4 v0 = acc[ai][bj][m][0] * rs, v1 = acc[ai][bj][m][1] * rs;
                    if (t < 2) {
                        f32x4 w0, w1;
                        w0[0] = v0[0] * c01[0] - v0[1] * c01[1]; w0[1] = v0[1] * c01[0] + v0[0] * c01[1];
                        w0[2] = v0[2] * c01[2] - v0[3] * c01[3]; w0[3] = v0[3] * c01[2] + v0[2] * c01[3];
                        w1[0] = v1[0] * c23[0] - v1[1] * c23[1]; w1[1] = v1[1] * c23[0] + v1[0] * c23[1];
                        w1[2] = v1[2] * c23[2] - v1[3] * c23[3]; w1[3] = v1[3] * c23[2] + v1[2] * c23[3];
                        v0 = w0 * qs; v1 = w1 * qs;
                    }
                    u32x4 w; w.x = cvt_pk_bf16(v0[0], v0[1]); w.y = cvt_pk_bf16(v0[2], v0[3]); w.z = cvt_pk_bf16(v1[0], v1[1]); w.w = cvt_pk_bf16(v1[2], v1[3]);
                    *(u32x4*)(rowp + bj * HALF) = w;
                }
            }
            asm volatile("" ::: "memory");
        }
    }
};
struct EpiHG {
    static constexpr bool PERM = true, AFTER_DRAIN = false;
    bf16_t* P; const PG8_LAS unsigned char* ss; const float* lb;
    __device__ __forceinline__ void operator()(const f32x4 (&acc)[2][2][4][2], const Unit& u, int wr, int wc, int fr, int fq) const {
        const int colt = u.pn * BM, t = colt >> 10;
        bf16_t* base = P + (size_t)t * TSTRIDE;
        const int col0 = (colt & 1023) + wc * 32 + 8 * fq;
        f32x4 lb0[2] = {{0.f, 0.f, 0.f, 0.f}, {0.f, 0.f, 0.f, 0.f}}, lb1[2] = {{0.f, 0.f, 0.f, 0.f}, {0.f, 0.f, 0.f, 0.f}};
        if (t == 1) {
#pragma unroll
            for (int bj = 0; bj < 2; ++bj) { lb0[bj] = *(const f32x4*)(lb + col0 + bj * HALF); lb1[bj] = *(const f32x4*)(lb + col0 + bj * HALF + 4); }
        }
        float rs8[8]; PG8_LOAD_RS(rs8, ss);
#pragma unroll
        for (int ai = 0; ai < 2; ++ai)
#pragma unroll
            for (int m = 0; m < 4; ++m) {
                const int row = u.pm * BM + ai * HALF + wr * 64 + m * 16 + fr;
                const float rs = rs8[ai * 4 + m];
                bf16_t* rowp = base + (size_t)row * 1024 + col0;
#pragma unroll
                for (int bj = 0; bj < 2; ++bj) {
                    f32x4 v0 = acc[ai][bj][m][0] * rs, v1 = acc[ai][bj][m][1] * rs;
                    u32x4 w;
                    if (t == 1) {
#pragma unroll
                        for (int j = 0; j < 4; ++j) {
                            v0[j] = __logf(lb0[bj][j] + (1.0f - lb0[bj][j]) * sigm(v0[j]));
                            v1[j] = __logf(lb1[bj][j] + (1.0f - lb1[bj][j]) * sigm(v1[j]));
                        }
                        w.x = pk_h2(v0[0], v0[1]); w.y = pk_h2(v0[2], v0[3]); w.z = pk_h2(v1[0], v1[1]); w.w = pk_h2(v1[2], v1[3]);
                    } else {
                        if (t != 2) {
#pragma unroll
                            for (int j = 0; j < 4; ++j) { v0[j] = silu(v0[j]); v1[j] = silu(v1[j]); }
                        }
                        w.x = cvt_pk_bf16(v0[0], v0[1]); w.y = cvt_pk_bf16(v0[2], v0[3]); w.z = cvt_pk_bf16(v1[0], v1[1]); w.w = cvt_pk_bf16(v1[2], v1[3]);
                    }
                    *(u32x4*)(rowp + bj * HALF) = w;
                }
            }
    }
};
struct EpiFFN {
    static constexpr bool PERM = true, AFTER_DRAIN = false;
    bf16_t* H; const PG8_LAS unsigned char* ss;
    __device__ __forceinline__ void operator()(const f32x4 (&acc)[2][2][4][2], const Unit& u, int wr, int wc, int fr, int fq) const {
        const int hcol0 = u.pn * HALF + wc * 32 + 8 * fq;
        float rs8[8]; PG8_LOAD_RS(rs8, ss);
#pragma unroll
        for (int ai = 0; ai < 2; ++ai)
#pragma unroll
            for (int m = 0; m < 4; ++m) {
                const int row = u.pm * BM + ai * HALF + wr * 64 + m * 16 + fr;
                const float rs = rs8[ai * 4 + m];
                const f32x4 g0 = acc[ai][0][m][0] * rs, g1 = acc[ai][0][m][1] * rs, u0 = acc[ai][1][m][0] * rs, u1 = acc[ai][1][m][1] * rs;
                u32x4 w; w.x = cvt_pk_bf16(silu(g0[0]) * u0[0], silu(g0[1]) * u0[1]); w.y = cvt_pk_bf16(silu(g0[2]) * u0[2], silu(g0[3]) * u0[3]);
                w.z = cvt_pk_bf16(silu(g1[0]) * u1[0], silu(g1[1]) * u1[1]); w.w = cvt_pk_bf16(silu(g1[2]) * u1[2], silu(g1[3]) * u1[3]);
                *(u32x4*)(H + (size_t)row * 2816 + hcol0) = w;
            }
    }
};
__device__ __forceinline__ float bfl(unsigned w) { return __builtin_bit_cast(float, w << 16); }
__device__ __forceinline__ float bfh(unsigned w) { return __builtin_bit_cast(float, w & 0xffff0000u); }
struct EpiRes {
    static constexpr bool PERM = true, AFTER_DRAIN = false;
    bf16_t* xn; float* ssn;
    __device__ __forceinline__ void operator()(const f32x4 (&acc)[2][2][4][2], const Unit& u, int wr, int wc, int fr, int fq) const {
        const int col0 = u.pn * BM + wc * 32 + 8 * fq;
#pragma unroll
        for (int ai = 0; ai < 2; ++ai) {
            u32x4 bres[4][2];
#pragma unroll
            for (int m = 0; m < 4; ++m)
#pragma unroll
                for (int bj = 0; bj < 2; ++bj) bres[m][bj] = *(const u32x4*)(xn + (size_t)(u.pm * BM + ai * HALF + wr * 64 + m * 16 + fr) * 1024 + col0 + bj * HALF);
#pragma unroll
            for (int m = 0; m < 4; ++m) {
                const int row = u.pm * BM + ai * HALF + wr * 64 + m * 16 + fr;
                bf16_t* rowp = xn + (size_t)row * 1024 + col0;
                float s = 0.f;
#pragma unroll
                for (int bj = 0; bj < 2; ++bj) {
                    const u32x4 b = bres[m][bj];
                    const f32x4 v0 = acc[ai][bj][m][0] + (f32x4){bfl(b.x), bfh(b.x), bfl(b.y), bfh(b.y)}, v1 = acc[ai][bj][m][1] + (f32x4){bfl(b.z), bfh(b.z), bfl(b.w), bfh(b.w)};
                    u32x4 w; w.x = cvt_pk_bf16(v0[0], v0[1]); w.y = cvt_pk_bf16(v0[2], v0[3]); w.z = cvt_pk_bf16(v1[0], v1[1]); w.w = cvt_pk_bf16(v1[2], v1[3]);
                    *(u32x4*)(rowp + bj * HALF) = w;
                    s += (bfl(w.x) * bfl(w.x) + bfh(w.x) * bfh(w.x)) + (bfl(w.y) * bfl(w.y) + bfh(w.y) * bfh(w.y));
                    s += (bfl(w.z) * bfl(w.z) + bfh(w.z) * bfh(w.z)) + (bfl(w.w) * bfl(w.w) + bfh(w.w) * bfh(w.w));
                }
                s += __shfl_xor(s, 16); s += __shfl_xor(s, 32);
                if (fq == 0) ssn[(size_t)row * 16 + u.pn * 4 + wc] = s;
            }
        }
    }
};
}
namespace pg8 {
template <class Epi, class Sched, bool ALIGN_EPI = false, bool SP2 = false>
__device__ __forceinline__ void gemm_phase(PG8_LAS unsigned char* lds, const Gemm g, const Sched& S, const Epi& E) {
    const int tid = mk_tid(), wid = __builtin_amdgcn_readfirstlane(tid >> 6), lane = tid & 63, wr = wid >> 2, wc = wid & 3, fr = lane & 15, fq = lane >> 4;
    const int K = g.K, nt = K / BK;
    unsigned voffA[2], voffB[2];
#pragma unroll
    for (int i = 0; i < 2; ++i) { int R, C; stage_rc(tid * 16 + i * 8192, R, C); const int Rb = Epi::PERM ? ((R & ~31) + perm32(R & 31)) : R;
        voffA[i] = (unsigned)(R * K + C) * 2u; voffB[i] = (unsigned)(Rb * K + C) * 2u; }
    const size_t kstep = (size_t)(BK * 2);
    const size_t hstep = (size_t)HALF * K * 2;
    const size_t tstep = 2 * hstep;
    const unsigned ldsw = (unsigned)wid * 1024u;
    const int aoff = lds_byte(wr * 64 + fr, fq * 8), boff = lds_byte(wc * 32 + fr, fq * 8);
#define PG8_SA(b, h) (((b) * 2 + (h)) * HTB)
#define PG8_SB(b, h) ((4 + (b) * 2 + (h)) * HTB)
#define PG8_STAGE(bufoff, gbase, voff) do { _Pragma("unroll") for (int _i = 0; _i < 2; ++_i) \
        __builtin_amdgcn_global_load_lds((const unsigned*)((const char*)(gbase) + (voff)[_i]), (PG8_LAS unsigned*)(lds + (bufoff) + ldsw + _i * 8192), 16, 0, 0); } while (0)
#define PG8_LDA(dst, b, h) do { _Pragma("unroll") for (int m = 0; m < 4; ++m) _Pragma("unroll") for (int k = 0; k < 2; ++k) dst[m][k] = *(const PG8_LAS bf16x8*)(lds + PG8_SA(b, h) + aoff + m * 2048 + k * 1024); } while (0)
#define PG8_LDB(dst, b, h) do { _Pragma("unroll") for (int n = 0; n < 2; ++n) _Pragma("unroll") for (int k = 0; k < 2; ++k) dst[n][k] = *(const PG8_LAS bf16x8*)(lds + PG8_SB(b, h) + boff + n * 2048 + k * 1024); } while (0)
#define PG8_MMA(ai, bj, At, Bt) do { __builtin_amdgcn_s_setprio(1); _Pragma("unroll") for (int m = 0; m < 4; ++m) _Pragma("unroll") for (int n = 0; n < 2; ++n) _Pragma("unroll") for (int k = 0; k < 2; ++k) \
        acc[ai][bj][m][n] = __builtin_amdgcn_mfma_f32_16x16x32_bf16(Bt[n][k], At[m][k], acc[ai][bj][m][n], 0, 0, 0); __builtin_amdgcn_s_setprio(0); } while (0)
#define PG8_WAIT_V(n) asm volatile("s_waitcnt vmcnt(" #n ")" ::: "memory")
#define PG8_WAIT_L(n) asm volatile("s_waitcnt lgkmcnt(" #n ")" ::: "memory")
#define PG8_BAR __builtin_amdgcn_s_barrier()
#define PG8_SCHED __builtin_amdgcn_sched_barrier(0)
    Unit cur, nxt; int ui = 0;
    if (!S.next(0, cur)) return;
    f32x4 acc[2][2][4][2];
#pragma unroll
    for (int a = 0; a < 2; ++a)
#pragma unroll
        for (int b = 0; b < 2; ++b)
#pragma unroll
            for (int m = 0; m < 4; ++m)
#pragma unroll
                for (int n = 0; n < 2; ++n) acc[a][b][m][n] = (f32x4){0.f, 0.f, 0.f, 0.f};
    bf16x8 At[4][2], B0[2][2], B1[2][2];
    const char* cA = (const char*)g.A + (size_t)cur.pm * tstep; const char* cB = (const char*)g.Bt + (size_t)cur.pn * tstep;
    S.a_ready(cur);
    if constexpr (SP2) {
        PG8_STAGE(PG8_SB(0, 0), cB, voffB); PG8_STAGE(PG8_SB(0, 1), cB + hstep, voffB); PG8_STAGE(PG8_SA(0, 0), cA, voffA); PG8_STAGE(PG8_SA(0, 1), cA + hstep, voffA);
        if (wr == 1) PG8_BAR;
        PG8_WAIT_V(2); PG8_BAR;
        PG8_STAGE(PG8_SB(1, 0), cB + kstep, voffB); PG8_STAGE(PG8_SA(1, 0), cA + kstep, voffA); PG8_STAGE(PG8_SB(1, 1), cB + hstep + kstep, voffB);
        PG8_WAIT_V(6); PG8_BAR;
    } else {
        PG8_STAGE(PG8_SB(0, 0), cB, voffB); PG8_STAGE(PG8_SA(0, 0), cA, voffA); PG8_STAGE(PG8_SB(0, 1), cB + hstep, voffB); PG8_STAGE(PG8_SA(0, 1), cA + hstep, voffA);
        if (wr == 1) PG8_BAR;
        PG8_WAIT_V(4); PG8_BAR;
        PG8_STAGE(PG8_SB(1, 0), cB + kstep, voffB); PG8_STAGE(PG8_SA(1, 0), cA + kstep, voffA); PG8_STAGE(PG8_SB(1, 1), cB + hstep + kstep, voffB);
        PG8_WAIT_V(6); PG8_BAR;
    }
    for (;;) {
        const bool has_next = S.next(ui + 1, nxt);
        const char* nA = has_next ? (const char*)g.A + (size_t)nxt.pm * tstep : cA; const char* nB = has_next ? (const char*)g.Bt + (size_t)nxt.pn * tstep : cB;
        for (int t = 0; t < nt; t += 2) {
            const bool last = (t == nt - 2);
            const char* a1 = cA + (size_t)(t + 1) * kstep;
            const char* a2 = last ? nA : cA + (size_t)(t + 2) * kstep; const char* b2 = last ? nB : cB + (size_t)(t + 2) * kstep;
            const char* a3 = a2 + kstep; const char* b3 = b2 + kstep;
            if (last && has_next) S.a_ready(nxt);
            if constexpr (SP2) {
            PG8_LDB(B0, 0, 0); PG8_LDB(B1, 0, 1); PG8_SCHED; PG8_LDA(At, 0, 0); PG8_STAGE(PG8_SA(1, 1), a1 + hstep, voffA);
            PG8_WAIT_V(8); PG8_WAIT_L(0); PG8_BAR; PG8_MMA(0, 0, At, B0); PG8_MMA(0, 1, At, B1); PG8_BAR; PG8_SCHED;
            PG8_LDA(At, 0, 1); PG8_STAGE(PG8_SB(0, 0), b2, voffB); PG8_STAGE(PG8_SB(0, 1), b2 + hstep, voffB); PG8_STAGE(PG8_SA(0, 0), a2, voffA);
            PG8_WAIT_V(8); PG8_WAIT_L(0); PG8_BAR; PG8_MMA(1, 0, At, B0); PG8_MMA(1, 1, At, B1); PG8_BAR; PG8_SCHED;
            PG8_LDB(B0, 1, 0); PG8_LDB(B1, 1, 1); PG8_SCHED; PG8_LDA(At, 1, 0); PG8_STAGE(PG8_SA(0, 1), a2 + hstep, voffA);
            PG8_WAIT_V(8); PG8_WAIT_L(0); PG8_BAR; PG8_MMA(0, 0, At, B0); PG8_MMA(0, 1, At, B1); PG8_BAR; PG8_SCHED;
            PG8_LDA(At, 1, 1); PG8_STAGE(PG8_SB(1, 0), b3, voffB); PG8_STAGE(PG8_SB(1, 1), b3 + hstep, voffB); PG8_STAGE(PG8_SA(1, 0), a3, voffA);
            PG8_WAIT_V(8); PG8_WAIT_L(0); PG8_BAR; PG8_MMA(1, 0, At, B0); PG8_MMA(1, 1, At, B1); PG8_BAR; PG8_SCHED;
            } else {
            PG8_LDB(B0, 0, 0); PG8_SCHED; PG8_LDA(At, 0, 0); PG8_STAGE(PG8_SA(1, 1), a1 + hstep, voffA);
            PG8_WAIT_L(8); PG8_BAR; PG8_WAIT_L(0); PG8_MMA(0, 0, At, B0); PG8_BAR; PG8_SCHED;
            PG8_LDB(B1, 0, 1); PG8_STAGE(PG8_SB(0, 0), b2, voffB);
            PG8_BAR; PG8_WAIT_L(0); PG8_MMA(0, 1, At, B1); PG8_BAR;
            PG8_LDA(At, 0, 1); PG8_STAGE(PG8_SA(0, 0), a2, voffA);
            PG8_BAR; PG8_WAIT_L(0); PG8_MMA(1, 0, At, B0); PG8_BAR; PG8_SCHED;
            PG8_STAGE(PG8_SB(0, 1), b2 + hstep, voffB);
            PG8_WAIT_V(6); PG8_BAR; PG8_MMA(1, 1, At, B1); PG8_BAR;
            PG8_LDB(B0, 1, 0); PG8_SCHED; PG8_LDA(At, 1, 0); PG8_STAGE(PG8_SA(0, 1), a2 + hstep, voffA);
            PG8_WAIT_L(8); PG8_BAR; PG8_WAIT_L(0); PG8_MMA(0, 0, At, B0); PG8_BAR; PG8_SCHED;
            PG8_LDB(B1, 1, 1); PG8_STAGE(PG8_SB(1, 0), b3, voffB);
            PG8_BAR; PG8_WAIT_L(0); PG8_MMA(0, 1, At, B1); PG8_BAR;
            PG8_LDA(At, 1, 1); PG8_STAGE(PG8_SA(1, 0), a3, voffA);
            PG8_BAR; PG8_WAIT_L(0); PG8_MMA(1, 0, At, B0); PG8_BAR; PG8_SCHED;
            PG8_STAGE(PG8_SB(1, 1), b3 + hstep, voffB);
            PG8_WAIT_V(6); PG8_BAR; PG8_MMA(1, 1, At, B1); PG8_BAR;
            }
        }
        if constexpr (ALIGN_EPI) { if (wr == 0) PG8_BAR; }
        if constexpr (!Epi::AFTER_DRAIN) { E(acc, cur, wr, wc, fr, fq); S.done(cur); }
        if (!has_next) break;
#pragma unroll
        for (int a = 0; a < 2; ++a)
#pragma unroll
            for (int b = 0; b < 2; ++b)
#pragma unroll
                for (int m = 0; m < 4; ++m)
#pragma unroll
                    for (int n = 0; n < 2; ++n) acc[a][b][m][n] = (f32x4){0.f, 0.f, 0.f, 0.f};
        cur = nxt; cA = nA; cB = nB; ++ui;
        if constexpr (ALIGN_EPI) { if (wr == 1) PG8_BAR; }
    }
    PG8_WAIT_V(0);
    if constexpr (!ALIGN_EPI) { if (wr == 0) PG8_BAR; }
    PG8_BAR;
    if constexpr (Epi::AFTER_DRAIN) { E.fused(acc, cur, wr, wc, fr, fq, lds, wid, lane); S.done(cur); }
#undef PG8_SA
#undef PG8_SB
#undef PG8_STAGE
#undef PG8_LDA
#undef PG8_LDB
#undef PG8_MMA
#undef PG8_WAIT_V
#undef PG8_WAIT_L
#undef PG8_BAR
#undef PG8_SCHED
}
}
namespace attn_body {
using bf16=__hip_bfloat16;
using bf16x8=__attribute__((ext_vector_type(8)))short;
using s16x4=__attribute__((ext_vector_type(4)))short;
using f32x16=__attribute__((ext_vector_type(16)))float;
using u32x4=__attribute__((ext_vector_type(4)))unsigned;
constexpr int SEQ=4096,D=64,DM=1024;
constexpr int NW=8,QBLK=32,QB=QBLK*NW,KVBLK=64,NQB=SEQ/QB;
constexpr int ATTN_PITCH=DM, ATTN_UNIT_ROWS=QB;
__device__ __forceinline__ int crow(int r,int hi){return (r&3)+8*(r>>2)+4*hi;}
#define SBAR() __builtin_amdgcn_sched_barrier(0)
__device__ __forceinline__ void cmask(f32x16&p0,f32x16&p1,int jb,int qrel,int hi){
  const float NEG=-INFINITY; int kb=64*jb+4*hi;
  #pragma unroll
  for(int r=0;r<16;++r){int kv=kb+(r&3)+8*(r>>2); if(kv>qrel)p0[r]=NEG; if(kv+32>qrel)p1[r]=NEG;}
}

constexpr int NSLOT=3, SLOTB=8192;
constexpr int LDS_K=0, LDS_V=NSLOT*SLOTB, LDS_WS=2*NSLOT*SLOTB, LDS_OST=LDS_WS+NW*64*4, LDS_BYTES=LDS_OST+NW*4096;
constexpr float C2=0.125f*1.4426950408889634f;
__device__ __forceinline__ void glds16(const void*gsrc,unsigned lds_dst){unsigned keep;
  asm volatile("s_mov_b32 %0, m0\n\ts_mov_b32 m0, %2\n\ts_nop 0\n\tglobal_load_lds_dwordx4 %1, off\n\ts_mov_b32 m0, %0":"=&s"(keep):"v"(gsrc),"s"(lds_dst):"memory");}
__device__ __forceinline__ float max3f(float a,float b,float c){float r;asm("v_max3_f32 %0, %1, %2, %3":"=v"(r):"v"(a),"v"(b),"v"(c));return r;}
__device__ __forceinline__ float max2f(float a,float b){float r;asm("v_max_f32_e32 %0, %1, %2":"=v"(r):"v"(a),"v"(b));return r;}
__device__ __forceinline__ float fadd_s(float a,float b){float r;asm("v_add_f32_e32 %0, %1, %2":"=v"(r):"v"(a),"v"(b));return r;}
__device__ __forceinline__ float fsub_s(float a,float b){float r;asm("v_sub_f32_e32 %0, %1, %2":"=v"(r):"v"(a),"v"(b));return r;}
typedef float f32x2_t __attribute__((ext_vector_type(2))); typedef __bf16 bf16x2_t __attribute__((ext_vector_type(2)));
__device__ __forceinline__ unsigned cvtpk_s(float lo,float hi){f32x2_t v={lo,hi};bf16x2_t b=__builtin_convertvector(v,bf16x2_t);return __builtin_bit_cast(unsigned,b);}
#define WAIT_BAR(N) asm volatile("s_waitcnt vmcnt(" #N ") lgkmcnt(0)\n\ts_barrier":::"memory")

__device__ __forceinline__ void qkt(f32x16&p0,f32x16&p1,const char*Kslot,const bf16x8*qr,const f32x16&negm,int r32,int hi){
  const char*kb=Kslot+hi*1024+r32*16;
  #pragma unroll
  for(int d0=0;d0<4;++d0){
    const bf16x8 b0=*reinterpret_cast<const bf16x8*>(kb+d0*2048);
    const bf16x8 b1=*reinterpret_cast<const bf16x8*>(kb+d0*2048+512);
    if(d0==0){p0=__builtin_amdgcn_mfma_f32_32x32x16_bf16(b0,qr[0],negm,0,0,0);p1=__builtin_amdgcn_mfma_f32_32x32x16_bf16(b1,qr[0],negm,0,0,0);}
    else{p0=__builtin_amdgcn_mfma_f32_32x32x16_bf16(b0,qr[d0],p0,0,0,0);p1=__builtin_amdgcn_mfma_f32_32x32x16_bf16(b1,qr[d0],p1,0,0,0);}}
}
typedef __attribute__((address_space(3))) const char* lds_cptr;
typedef short v4i16_t __attribute__((ext_vector_type(4)));
__device__ __forceinline__ void kload8(bf16x8*kf,lds_cptr kp){
  kf[0]=*(const __attribute__((address_space(3))) bf16x8*)(kp);      kf[1]=*(const __attribute__((address_space(3))) bf16x8*)(kp+512);
  kf[2]=*(const __attribute__((address_space(3))) bf16x8*)(kp+2048); kf[3]=*(const __attribute__((address_space(3))) bf16x8*)(kp+2560);
  kf[4]=*(const __attribute__((address_space(3))) bf16x8*)(kp+4096); kf[5]=*(const __attribute__((address_space(3))) bf16x8*)(kp+4608);
  kf[6]=*(const __attribute__((address_space(3))) bf16x8*)(kp+6144); kf[7]=*(const __attribute__((address_space(3))) bf16x8*)(kp+6656);
}
__device__ __forceinline__ void kload2(bf16x8*kf,lds_cptr kp,int j){ kf[2*j]=*(const __attribute__((address_space(3))) bf16x8*)(kp+j*2048); kf[2*j+1]=*(const __attribute__((address_space(3))) bf16x8*)(kp+j*2048+512); }
__device__ __forceinline__ s16x4 vtr(lds_cptr p){ return __builtin_bit_cast(s16x4,__builtin_amdgcn_ds_read_tr16_b64_v4i16((__attribute__((address_space(3))) v4i16_t*)p)); }
__device__ __forceinline__ float rowmax(const f32x16&p0,const f32x16&p1){
  float a=max3f(p0[0],p0[1],p1[0]),b=max3f(p0[2],p0[3],p1[1]);a=max3f(a,p1[2],p1[3]);
  #pragma unroll
  for(int r=4;r<16;r+=4){a=max3f(a,p0[r],p0[r+1]);b=max3f(b,p0[r+2],p0[r+3]);a=max3f(a,p1[r],p1[r+1]);b=max3f(b,p1[r+2],p1[r+3]);}
  const float m=max2f(a,b);
  auto rr=__builtin_amdgcn_permlane32_swap(__float_as_uint(m),__float_as_uint(m),false,false);
  return max2f(__uint_as_float(rr[0]),__uint_as_float(rr[1]));
}
__device__ __forceinline__ void pv(f32x16*o,int vb,bf16x8 pa0,bf16x8 pa1,bf16x8 pa2,bf16x8 pa3){
  #pragma unroll
  for(int d0=0;d0<2;++d0){s16x4 lo[4],hi[4];
    #pragma unroll
    for(int ks=0;ks<4;++ks){
      asm volatile("ds_read_b64_tr_b16 %0,%1 offset:%c2":"=&v"(lo[ks]):"v"(vb),"i"(d0*4096+ks*1024):"memory");
      asm volatile("ds_read_b64_tr_b16 %0,%1 offset:%c2":"=&v"(hi[ks]):"v"(vb),"i"(d0*4096+ks*1024+512):"memory");}
    asm volatile("s_waitcnt lgkmcnt(0)":::"memory");SBAR();
    #define PK(k) (bf16x8){lo[k][0],lo[k][1],lo[k][2],lo[k][3],hi[k][0],hi[k][1],hi[k][2],hi[k][3]}
    o[d0]=__builtin_amdgcn_mfma_f32_32x32x16_bf16(pa0,PK(0),o[d0],0,0,0);
    o[d0]=__builtin_amdgcn_mfma_f32_32x32x16_bf16(pa1,PK(1),o[d0],0,0,0);
    o[d0]=__builtin_amdgcn_mfma_f32_32x32x16_bf16(pa2,PK(2),o[d0],0,0,0);
    o[d0]=__builtin_amdgcn_mfma_f32_32x32x16_bf16(pa3,PK(3),o[d0],0,0,0);
    #undef PK
  }
}

#ifndef ATTN_STORE16
#define ATTN_STORE16(p,v) (*(u32x4*)(p)=(v))
#endif
template<int THRL> __device__ __forceinline__ void attn_unit(int b,int qcol,int vcol,int qb,const bf16*Q,const bf16*__restrict__ K,const bf16*__restrict__ V,bf16*O,char*shm){
  const int tid=mk_tid(),lane=tid&63,r32=lane&31,hi=lane>>5; const int wid=__builtin_amdgcn_readfirstlane(tid>>6);
  const long rowbase=(long)b*SEQ; const int q0=qb*QB;
  const bf16*Qw=Q+(rowbase+q0+wid*QBLK)*DM+qcol;
  const bf16*Kh=K+rowbase*DM+qcol,*Vh=V+rowbase*DM+vcol;
  const unsigned lds0=(unsigned)(uintptr_t)shm;
  float*wsf=(float*)(shm+LDS_WS)+wid*64;
  const bf16*ksrc=Kh+(long)lane*DM+wid*8;
  const bf16*vsrc=Vh+(long)(16*(wid&3)+(lane>>2))*DM+(wid>>2)*32+(lane&3)*8;
  const unsigned kdst=lds0+LDS_K+wid*1024, vdst=lds0+LDS_V+wid*1024;
  #define DMA_K(t,slot) glds16(ksrc+(long)(t)*KVBLK*DM,(unsigned)__builtin_amdgcn_readfirstlane(kdst+(slot)))
  #define DMA_V(t,slot) glds16(vsrc+(long)(t)*KVBLK*DM,(unsigned)__builtin_amdgcn_readfirstlane(vdst+(slot)))
  const int vb0=(int)(lds0+LDS_V)+((lane>>4)&1)*32+(lane&3)*8+(4*hi+((lane&15)>>2))*64;
  const char*Kbase=shm+LDS_K; bf16x8 kf[8];
  const lds_cptr shm3=(lds_cptr)shm; const lds_cptr kp0=shm3+LDS_K+hi*1024+r32*16; const lds_cptr vp0=shm3+LDS_V+((lane>>4)&1)*32+(lane&3)*8+(4*hi+((lane&15)>>2))*64;
  const int NT=(q0+QB)/KVBLK;
  DMA_K(0,0);DMA_V(0,0);DMA_K(1,SLOTB);
  bf16x8 qr[4];
  #pragma unroll
  for(int d0=0;d0<4;++d0)qr[d0]=*reinterpret_cast<const bf16x8*>(&Qw[(long)r32*DM+d0*16+hi*8]);
  float mhat=0.f,l_reg=0.f;f32x16 o[2];o[0]=f32x16{};o[1]=f32x16{};f32x16 negm=f32x16{};asm volatile("":"+v"(negm));
  const int qrel=wid*QBLK+r32;
  #define CMASK(P0,P1,t) do{int jb_=(t)-(NT-4); if(jb_>=0)cmask(P0,P1,jb_,qrel,hi);}while(0)
  bool resc=false;
  #define START(P0,P1) do{ const float rm=rowmax(P0,P1); resc=false; \
    { const float dl=rm; mhat=fadd_s(mhat,dl); \
      _Pragma("unroll") for(int r=0;r<16;++r){P0[r]=fsub_s(P0[r],dl);P1[r]=fsub_s(P1[r],dl);} \
      _Pragma("unroll") for(int r=0;r<16;++r)negm[r]=-mhat; asm volatile("":"+v"(negm)); } \
    _Pragma("unroll") for(int r=0;r<16;++r)P0[r]=__builtin_amdgcn_exp2f(P0[r]); }while(0)
  #define RESC() do{ if(resc){ asm volatile("s_waitcnt lgkmcnt(0)":::"memory"); \
      _Pragma("unroll") for(int d_=0;d_<2;++d_) _Pragma("unroll") for(int r=0;r<16;++r)o[d_][r]*=wsf[crow(r,hi)]; } }while(0)
  f32x16 pA0,pA1,pB0,pB1;
  int sl_prev=0,sl_cur=0,sl_next=SLOTB;
  #define ROT() do{sl_prev=sl_cur;sl_cur=sl_next;sl_next=(sl_next==(NSLOT-1)*SLOTB)?0:sl_next+SLOTB;}while(0)
  DMA_K(2,2*SLOTB);
  WAIT_BAR(3);
  qkt(pA0,pA1,Kbase,qr,negm,r32,hi);asm volatile("s_nop 15\n\ts_nop 7":"+v"(pA0),"+v"(pA1));CMASK(pA0,pA1,0);
  START(pA0,pA1);
  _Pragma("unroll") for(int r=0;r<16;++r)pA1[r]=__builtin_amdgcn_exp2f(pA1[r]);
  WAIT_BAR(0);
  DMA_K(3,0);DMA_V(1,SLOTB);
  ROT();
  kload8(kf,kp0+sl_cur);
  WAIT_BAR(2);
  s16x4 vlo[8],vhi[8]; u32x4 pw0,pw1,pw2,pw3;
  #define PKW(P,B) cvtpk_s(P[B],P[B+1])
  #define PAF(k) __builtin_bit_cast(bf16x8,pw##k)
  #define VFR(i) (bf16x8){vlo[i][0],vlo[i][1],vlo[i][2],vlo[i][3],vhi[i][0],vhi[i][1],vhi[i][2],vhi[i][3]}
  #define PIN(x) asm volatile("":"+v"(x))
  #define MX3(a,b,c) __builtin_fmaxf(__builtin_fmaxf((a),(b)),(c))
  #define GAPA(MF,A0,A1,A2,A3,W0,W1,PW) do{ MF; sacc+=A0; sacc+=A1; sacc+=A2; sacc+=A3; PIN(sacc); W0; W1; PIN(PW); SBAR(); }while(0)
  #define EX(v) __builtin_amdgcn_exp2f(v)
  #define GAPB(MF,X,B) do{ MF; X[B]=EX(X[B]); X[B+1]=EX(X[B+1]); X[B+2]=EX(X[B+2]); X[B+3]=EX(X[B+3]); PIN(X); SBAR(); }while(0)
  #define VRD(i) do{ vlo[i]=vtr(vp_+(((i)>>2)*4096+((i)&3)*1024)); vhi[i]=vtr(vp_+(((i)>>2)*4096+((i)&3)*1024+512)); }while(0)
  #define KRD(G,j) do{ if(G){ kload2(kf,kp0+sl_next,j); SBAR(); } }while(0)
  #define STEP(C0,C1,P0,P1,t,GK,GV,GL) do{ SBAR(); \
    const lds_cptr vp_=vp0+sl_prev; \
    VRD(0); SBAR(); float sacc=(P0[0]+P0[1]); \
    GAPA(C0=__builtin_amdgcn_mfma_f32_32x32x16_bf16(kf[0],qr[0],negm,0,0,0), P0[2],P0[3],P0[4],P0[5],     pw0[0]=PKW(P0,0), pw0[1]=PKW(P0,2), pw0); \
    VRD(4); SBAR(); GAPA(C1=__builtin_amdgcn_mfma_f32_32x32x16_bf16(kf[1],qr[0],negm,0,0,0), P0[6],P0[7],P0[8],P0[9],     pw0[2]=PKW(P0,4), pw0[3]=PKW(P0,6), pw0); \
    VRD(1); SBAR(); GAPA(C0=__builtin_amdgcn_mfma_f32_32x32x16_bf16(kf[2],qr[1],C0,0,0,0),   P0[10],P0[11],P0[12],P0[13], pw1[0]=PKW(P0,8), pw1[1]=PKW(P0,10), pw1); \
    VRD(5); SBAR(); GAPA(C1=__builtin_amdgcn_mfma_f32_32x32x16_bf16(kf[3],qr[1],C1,0,0,0),   P0[14],P0[15],P1[0],P1[1],   pw1[2]=PKW(P0,12),pw1[3]=PKW(P0,14), pw1); \
    VRD(2); SBAR(); GAPA(C0=__builtin_amdgcn_mfma_f32_32x32x16_bf16(kf[4],qr[2],C0,0,0,0),   P1[2],P1[3],P1[4],P1[5],     pw2[0]=PKW(P1,0), pw2[1]=PKW(P1,2), pw2); \
    VRD(6); SBAR(); GAPA(C1=__builtin_amdgcn_mfma_f32_32x32x16_bf16(kf[5],qr[2],C1,0,0,0),   P1[6],P1[7],P1[8],P1[9],     pw2[2]=PKW(P1,4), pw2[3]=PKW(P1,6), pw2); \
    VRD(3); SBAR(); GAPA(C0=__builtin_amdgcn_mfma_f32_32x32x16_bf16(kf[6],qr[3],C0,0,0,0),   P1[10],P1[11],P1[12],P1[13], pw3[0]=PKW(P1,8), pw3[1]=PKW(P1,10), pw3); \
    VRD(7); SBAR(); GAPA(C1=__builtin_amdgcn_mfma_f32_32x32x16_bf16(kf[7],qr[3],C1,0,0,0),   P1[14],P1[15],0.f,0.f,       pw3[2]=PKW(P1,12),pw3[3]=PKW(P1,14), pw3); \
    l_reg+=sacc; \
    if(GK){DMA_K((t)+3,sl_cur);} if(GV){DMA_V((t)+1,sl_next);} \
    CMASK(C0,C1,t); \
    { float a=MX3(C0[0],C0[1],C1[0]),b=MX3(C0[2],C0[3],C1[1]); a=MX3(a,C1[2],C1[3]); \
      _Pragma("unroll") for(int r=4;r<16;r+=4){a=MX3(a,C0[r],C0[r+1]);b=MX3(b,C0[r+2],C0[r+3]);a=MX3(a,C1[r],C1[r+1]);b=MX3(b,C1[r+2],C1[r+3]);} \
      float rm=__builtin_fmaxf(a,b); { auto rr=__builtin_amdgcn_permlane32_swap(__float_as_uint(rm),__float_as_uint(rm),false,false); rm=__builtin_fmaxf(__uint_as_float(rr[0]),__uint_as_float(rr[1])); } \
      resc=false; \
      if(__builtin_expect(__any(rm>(float)THRL),0)){ const float dl=__builtin_fmaxf(rm,0.f); mhat+=dl; \
        _Pragma("unroll") for(int r=0;r<16;++r){C0[r]-=dl;C1[r]-=dl;} \
        _Pragma("unroll") for(int r=0;r<16;++r)negm[r]=-mhat; asm volatile("":"+v"(negm)); \
        const float f=__builtin_amdgcn_exp2f(-dl); l_reg*=f; if(hi==0)wsf[r32]=f; resc=true; } } \
    SBAR(); \
    GAPB(o[0]=__builtin_amdgcn_mfma_f32_32x32x16_bf16(PAF(0),VFR(0),o[0],0,0,0), C0,0); \
    GAPB(o[1]=__builtin_amdgcn_mfma_f32_32x32x16_bf16(PAF(0),VFR(4),o[1],0,0,0), C0,4); \
    KRD(GL,0); GAPB(o[0]=__builtin_amdgcn_mfma_f32_32x32x16_bf16(PAF(1),VFR(1),o[0],0,0,0), C0,8); \
    KRD(GL,1); GAPB(o[1]=__builtin_amdgcn_mfma_f32_32x32x16_bf16(PAF(1),VFR(5),o[1],0,0,0), C0,12); \
    KRD(GL,2); GAPB(o[0]=__builtin_amdgcn_mfma_f32_32x32x16_bf16(PAF(2),VFR(2),o[0],0,0,0), C1,0); \
    KRD(GL,3); GAPB(o[1]=__builtin_amdgcn_mfma_f32_32x32x16_bf16(PAF(2),VFR(6),o[1],0,0,0), C1,4); \
    GAPB(o[0]=__builtin_amdgcn_mfma_f32_32x32x16_bf16(PAF(3),VFR(3),o[0],0,0,0), C1,8); \
    GAPB(o[1]=__builtin_amdgcn_mfma_f32_32x32x16_bf16(PAF(3),VFR(7),o[1],0,0,0), C1,12); \
    }while(0)
  int t=1;
  #undef CMASK
  #define CMASK(P0,P1,t) do{}while(0)
  for(;t+5<NT;t+=2){
    STEP(pB0,pB1,pA0,pA1,t,true,true,true);     WAIT_BAR(2); RESC(); ROT();
    STEP(pA0,pA1,pB0,pB1,t+1,true,true,true);   WAIT_BAR(2); RESC(); ROT();
  }
  #undef CMASK
  #define CMASK(P0,P1,t) do{int jb_=(t)-(NT-4); if(jb_>=0)cmask(P0,P1,jb_,qrel,hi);}while(0)
  #define ENDW(tt) do{ if((tt)+3<NT){WAIT_BAR(2);} else if((tt)+2<NT){WAIT_BAR(1);} else {WAIT_BAR(0);} }while(0)
  for(;t+1<NT;t+=2){
    STEP(pB0,pB1,pA0,pA1,t,(t+3<NT),(t+1<NT),(t+1<NT));       ENDW(t);   RESC(); ROT();
    STEP(pA0,pA1,pB0,pB1,t+1,(t+4<NT),(t+2<NT),(t+2<NT));     ENDW(t+1); RESC(); ROT();
  }
  STEP(pB0,pB1,pA0,pA1,NT-1,false,false,false); RESC();
  { float sacc=pB0[0]+pB0[1]; _Pragma("unroll") for(int r=2;r<16;++r)sacc+=pB0[r]; _Pragma("unroll") for(int r=0;r<16;++r)sacc+=pB1[r]; l_reg+=sacc;
    pw0=(u32x4){PKW(pB0,0),PKW(pB0,2),PKW(pB0,4),PKW(pB0,6)};pw1=(u32x4){PKW(pB0,8),PKW(pB0,10),PKW(pB0,12),PKW(pB0,14)};pw2=(u32x4){PKW(pB1,0),PKW(pB1,2),PKW(pB1,4),PKW(pB1,6)};pw3=(u32x4){PKW(pB1,8),PKW(pB1,10),PKW(pB1,12),PKW(pB1,14)};
    SBAR(); pv(o,vb0+sl_cur,PAF(0),PAF(1),PAF(2),PAF(3)); }
  #undef PKW
  #undef PAF
  #undef VFR
  #undef PIN
  #undef MX3
  #undef GAPA
  #undef GAPB
  #undef EX
  #undef VRD
  #undef KRD
  #undef STEP
  #undef ENDW
  {auto rr=__builtin_amdgcn_permlane32_swap(__float_as_uint(l_reg),__float_as_uint(l_reg),false,false);l_reg=__uint_as_float(rr[0])+__uint_as_float(rr[1]);}
  if(hi==0)wsf[32+r32]=l_reg;asm volatile("s_waitcnt lgkmcnt(0)":::"memory");
  float rli[16];
  #pragma unroll
  for(int r=0;r<16;++r)rli[r]=__builtin_amdgcn_rcpf(wsf[32+crow(r,hi)]);
  bf16*Ow=O+(rowbase+q0+wid*QBLK)*DM+vcol;
  { _Float16*stg=(_Float16*)(shm+LDS_OST)+wid*2048;
    #pragma unroll
    for(int r=0;r<16;++r){const int orow=crow(r,hi);
      #pragma unroll
      for(int d0=0;d0<2;++d0)stg[orow*64+d0*32+r32]=(_Float16)(o[d0][r]*rli[r]);}
    asm volatile("s_waitcnt lgkmcnt(0)":::"memory");
    #pragma unroll
    for(int i=0;i<4;++i){const int row=i*8+(lane>>3),ch=lane&7; const u32x4 v=*(const u32x4*)(stg+row*64+ch*8); ATTN_STORE16(Ow+(long)row*DM+ch*8,v);} }
  asm volatile("s_waitcnt lgkmcnt(0)\n\ts_barrier":::"memory");
  #undef DMA_K
  #undef DMA_V
  #undef CMASK
  #undef START
  #undef RESC
  #undef ROT
}

__device__ __forceinline__ void pv4(f32x16*o,lds_cptr vp,bf16x8 pa0,bf16x8 pa1,bf16x8 pa2,bf16x8 pa3){
  #pragma unroll
  for(int d0=0;d0<4;++d0){
    s16x4 lo[4],hi[4];
    #pragma unroll
    for(int ks=0;ks<4;++ks){ lo[ks]=vtr(vp+(d0*4096+ks*1024)); hi[ks]=vtr(vp+(d0*4096+ks*1024+512)); }
    #define PKF(k) (bf16x8){lo[k][0],lo[k][1],lo[k][2],lo[k][3],hi[k][0],hi[k][1],hi[k][2],hi[k][3]}
    o[d0]=__builtin_amdgcn_mfma_f32_32x32x16_bf16(pa0,PKF(0),o[d0],0,0,0);
    o[d0]=__builtin_amdgcn_mfma_f32_32x32x16_bf16(pa1,PKF(1),o[d0],0,0,0);
    o[d0]=__builtin_amdgcn_mfma_f32_32x32x16_bf16(pa2,PKF(2),o[d0],0,0,0);
    o[d0]=__builtin_amdgcn_mfma_f32_32x32x16_bf16(pa3,PKF(3),o[d0],0,0,0);
    #undef PKF
  }
}
__device__ __forceinline__ float rowmax_c(const f32x16&p0,const f32x16&p1){
  float a=__builtin_fmaxf(__builtin_fmaxf(p0[0],p0[1]),p1[0]),b=__builtin_fmaxf(__builtin_fmaxf(p0[2],p0[3]),p1[1]); a=__builtin_fmaxf(__builtin_fmaxf(a,p1[2]),p1[3]);
  #pragma unroll
  for(int r=4;r<16;r+=4){a=__builtin_fmaxf(__builtin_fmaxf(a,p0[r]),p0[r+1]);b=__builtin_fmaxf(__builtin_fmaxf(b,p0[r+2]),p0[r+3]);a=__builtin_fmaxf(__builtin_fmaxf(a,p1[r]),p1[r+1]);b=__builtin_fmaxf(__builtin_fmaxf(b,p1[r+2]),p1[r+3]);}
  float rm=__builtin_fmaxf(a,b);
  auto rr=__builtin_amdgcn_permlane32_swap(__float_as_uint(rm),__float_as_uint(rm),false,false);
  return __builtin_fmaxf(__uint_as_float(rr[0]),__uint_as_float(rr[1]));
}
constexpr int A128_KS=8192, A128_VS=16384, A128_NS=3, A128_NV=4;
constexpr int A128_K=0, A128_V=A128_NS*A128_KS, A128_WS=A128_V+A128_NV*A128_VS, A128_OST=A128_WS+NW*64*4, A128_BYTES=A128_OST+NW*4096;
template<int THRL> __device__ __forceinline__ void attn128_unit(int b,int qcol,int vcol,int qb,const bf16*Q,const bf16*__restrict__ K,const bf16*__restrict__ V,bf16*O,char*shm){
  const int tid=mk_tid(),lane=tid&63,r32=lane&31,hi=lane>>5; const int wid=__builtin_amdgcn_readfirstlane(tid>>6);
  const long rowbase=(long)b*SEQ; const int q0=qb*QB;
  const bf16*Qw=Q+(rowbase+q0+wid*QBLK)*DM+qcol;
  const bf16*Kh=K+rowbase*DM+qcol,*Vh=V+rowbase*DM+vcol;
  const unsigned lds0=(unsigned)(uintptr_t)shm;
  float*wsf=(float*)(shm+A128_WS)+wid*64;
  const bf16*ksrc=Kh+(long)lane*DM+wid*8;
  const bf16*vsrc=Vh+(long)(16*(wid&3)+(lane>>2))*DM+(wid>>2)*32+(lane&3)*8;
  const unsigned kdst=lds0+A128_K+wid*1024, vdst=lds0+A128_V+wid*1024;
  #define DMA_T(t,sl,sv) do{ glds16(ksrc+(long)(t)*KVBLK*DM,(unsigned)__builtin_amdgcn_readfirstlane(kdst+(sl)*A128_KS)); \
      glds16(vsrc+(long)(t)*KVBLK*DM,(unsigned)__builtin_amdgcn_readfirstlane(vdst+(sv)*A128_VS)); \
      glds16(vsrc+(long)(t)*KVBLK*DM+64,(unsigned)__builtin_amdgcn_readfirstlane(vdst+(sv)*A128_VS+8192)); }while(0)
  const lds_cptr vb0=(lds_cptr)shm+A128_V+((lane>>4)&1)*32+(lane&3)*8+(4*hi+((lane&15)>>2))*64;
  const int NT=(q0+QB)/KVBLK;
  bf16x8 qr[4];
  #pragma unroll
  for(int d0=0;d0<4;++d0)qr[d0]=*reinterpret_cast<const bf16x8*>(&Qw[(long)r32*DM+d0*16+hi*8]);
  DMA_T(0,0,0); DMA_T(1,1,1);
  const bool skew=(wid>=4);
  u32x4 pw0={0u,0u,0u,0u},pw1=pw0,pw2=pw0,pw3=pw0;
  float mhat=0.f,l_reg=0.f; f32x16 o[4]; o[0]=f32x16{};o[1]=f32x16{};o[2]=f32x16{};o[3]=f32x16{}; f32x16 negm=f32x16{};
  const int qrel=wid*QBLK+r32;
  int sl=0,sv=0;
  for(int t=0;t<NT;++t){
    if(t+1<NT){WAIT_BAR(3);}else{WAIT_BAR(0);}
    if(t+2<NT){const int s2=(sl==0)?2:sl-1; DMA_T(t+2,s2,(sv+2)&3);}
    if(skew&&t>0) pv4(o,vb0+((sv+3)&3)*A128_VS,__builtin_bit_cast(bf16x8,pw0),__builtin_bit_cast(bf16x8,pw1),__builtin_bit_cast(bf16x8,pw2),__builtin_bit_cast(bf16x8,pw3));
    f32x16 p0,p1;
    qkt(p0,p1,shm+A128_K+sl*A128_KS,qr,negm,r32,hi);
    { const int jb_=t-(NT-4); if(jb_>=0)cmask(p0,p1,jb_,qrel,hi); }
    const float rm=rowmax_c(p0,p1);
    bool resc=false;
    if(t==0){ const float dl=rm; mhat+=dl;
      #pragma unroll
      for(int r=0;r<16;++r){p0[r]-=dl;p1[r]-=dl;}
      #pragma unroll
      for(int r=0;r<16;++r)negm[r]=-mhat; }
    else if(__any(rm>(float)THRL)){ const float dl=__builtin_fmaxf(rm,0.f); mhat+=dl;
      #pragma unroll
      for(int r=0;r<16;++r){p0[r]-=dl;p1[r]-=dl;}
      #pragma unroll
      for(int r=0;r<16;++r)negm[r]=-mhat;
      const float f=__builtin_amdgcn_exp2f(-dl); l_reg*=f; if(hi==0)wsf[r32]=f; resc=true; }
    if(resc){ asm volatile("s_waitcnt lgkmcnt(0)":::"memory");
      #pragma unroll
      for(int d_=0;d_<4;++d_)
        #pragma unroll
        for(int r=0;r<16;++r)o[d_][r]*=wsf[crow(r,hi)]; }
    float sacc=0.f;
    #pragma unroll
    for(int r=0;r<16;++r){p0[r]=__builtin_amdgcn_exp2f(p0[r]);p1[r]=__builtin_amdgcn_exp2f(p1[r]);sacc+=p0[r]+p1[r];}
    l_reg+=sacc;
    pw0=(u32x4){cvtpk_s(p0[0],p0[1]),cvtpk_s(p0[2],p0[3]),cvtpk_s(p0[4],p0[5]),cvtpk_s(p0[6],p0[7])}; pw1=(u32x4){cvtpk_s(p0[8],p0[9]),cvtpk_s(p0[10],p0[11]),cvtpk_s(p0[12],p0[13]),cvtpk_s(p0[14],p0[15])};
    pw2=(u32x4){cvtpk_s(p1[0],p1[1]),cvtpk_s(p1[2],p1[3]),cvtpk_s(p1[4],p1[5]),cvtpk_s(p1[6],p1[7])}; pw3=(u32x4){cvtpk_s(p1[8],p1[9]),cvtpk_s(p1[10],p1[11]),cvtpk_s(p1[12],p1[13]),cvtpk_s(p1[14],p1[15])};
    if(!skew) pv4(o,vb0+sv*A128_VS,__builtin_bit_cast(bf16x8,pw0),__builtin_bit_cast(bf16x8,pw1),__builtin_bit_cast(bf16x8,pw2),__builtin_bit_cast(bf16x8,pw3));
    sl=(sl==2)?0:sl+1; sv=(sv+1)&3;
  }
  if(skew) pv4(o,vb0+((sv+3)&3)*A128_VS,__builtin_bit_cast(bf16x8,pw0),__builtin_bit_cast(bf16x8,pw1),__builtin_bit_cast(bf16x8,pw2),__builtin_bit_cast(bf16x8,pw3));
  {auto rr=__builtin_amdgcn_permlane32_swap(__float_as_uint(l_reg),__float_as_uint(l_reg),false,false);l_reg=__uint_as_float(rr[0])+__uint_as_float(rr[1]);}
  if(hi==0)wsf[32+r32]=l_reg;asm volatile("s_waitcnt lgkmcnt(0)":::"memory");
  float rli[16];
  #pragma unroll
  for(int r=0;r<16;++r)rli[r]=__builtin_amdgcn_rcpf(wsf[32+crow(r,hi)]);
  bf16*Ow=O+(rowbase+q0+wid*QBLK)*DM+vcol;
  _Float16*stg=(_Float16*)(shm+A128_OST)+wid*2048;
  #pragma unroll
  for(int dh=0;dh<2;++dh){
    #pragma unroll
    for(int r=0;r<16;++r){const int orow=crow(r,hi);
      #pragma unroll
      for(int d0=0;d0<2;++d0)stg[orow*64+d0*32+r32]=(_Float16)(o[dh*2+d0][r]*rli[r]);}
    asm volatile("s_waitcnt lgkmcnt(0)":::"memory");
    #pragma unroll
    for(int i=0;i<4;++i){const int row=i*8+(lane>>3),ch=lane&7; const u32x4 v=*(const u32x4*)(stg+row*64+ch*8); ATTN_STORE16(Ow+(long)row*DM+dh*64+ch*8,v);}
    asm volatile("s_waitcnt lgkmcnt(0)":::"memory");
  }
  asm volatile("s_waitcnt lgkmcnt(0)\n\ts_barrier":::"memory");
  #undef DMA_T
}

constexpr int B128_KS=16384, B128_VS=32768;
constexpr int B128_K=0, B128_V=2*B128_KS, B128_WS=B128_V+2*B128_VS, B128_BYTES=B128_WS+NW*64*4;
static_assert(B128_BYTES<=131072,"attention scratch stays below the LDS control words");
template<int THRL> __device__ __forceinline__ void attn128x2_unit(int b,int qcol,int vcol,int qb,const bf16*Q,const bf16*__restrict__ K,const bf16*__restrict__ V,bf16*O,char*shm){
  const int tid=mk_tid(),lane=tid&63,r32=lane&31,hi=lane>>5; const int wid=__builtin_amdgcn_readfirstlane(tid>>6);
  const long rowbase=(long)b*SEQ; const int q0=qb*QB;
  const bf16*Qw=Q+(rowbase+q0+wid*QBLK)*DM+qcol;
  const bf16*Kh=K+rowbase*DM+qcol,*Vh=V+rowbase*DM+vcol;
  const unsigned lds0=(unsigned)(uintptr_t)shm;
  float*wsf=(float*)(shm+B128_WS)+wid*64;
  const bf16*ksrc=Kh+(long)lane*DM+wid*8;
  const bf16*vsrc=Vh+(long)(16*(wid&3)+(lane>>2))*DM+(wid>>2)*32+(lane&3)*8;
  const unsigned kdst=lds0+B128_K+wid*1024, vdst=lds0+B128_V+wid*1024;
  #define DMA_S(t,sl) do{ _Pragma("unroll") for(int u_=0;u_<2;++u_){ \
      glds16(ksrc+(long)(2*(t)+u_)*KVBLK*DM,(unsigned)__builtin_amdgcn_readfirstlane(kdst+(sl)*B128_KS+u_*8192)); \
      glds16(vsrc+(long)(2*(t)+u_)*KVBLK*DM,(unsigned)__builtin_amdgcn_readfirstlane(vdst+(sl)*B128_VS+u_*16384)); \
      glds16(vsrc+(long)(2*(t)+u_)*KVBLK*DM+64,(unsigned)__builtin_amdgcn_readfirstlane(vdst+(sl)*B128_VS+u_*16384+8192)); } }while(0)
  const lds_cptr vb0=(lds_cptr)shm+B128_V+((lane>>4)&1)*32+(lane&3)*8+(4*hi+((lane&15)>>2))*64;
  const int NS=(q0+QB)/(2*KVBLK);
  bf16x8 qr[4];
  #pragma unroll
  for(int d0=0;d0<4;++d0)qr[d0]=*reinterpret_cast<const bf16x8*>(&Qw[(long)r32*DM+d0*16+hi*8]);
  DMA_S(0,0);
  float mhat=0.f,l_reg=0.f; f32x16 o[4]; o[0]=f32x16{};o[1]=f32x16{};o[2]=f32x16{};o[3]=f32x16{}; f32x16 negm=f32x16{};
  const int qrel=wid*QBLK+r32;
  for(int t=0;t<NS;++t){
    const int sl=t&1;
    WAIT_BAR(0);
    if(t+1<NS) DMA_S(t+1,sl^1);
    f32x16 a0,a1,b0,b1;
    qkt(a0,a1,shm+B128_K+sl*B128_KS,qr,negm,r32,hi);
    qkt(b0,b1,shm+B128_K+sl*B128_KS+8192,qr,negm,r32,hi);
    { const int jb_=2*(t-(NS-2)); if(jb_>=0){ cmask(a0,a1,jb_,qrel,hi); cmask(b0,b1,jb_+1,qrel,hi); } }
    const float rm=__builtin_fmaxf(rowmax_c(a0,a1),rowmax_c(b0,b1));
    bool resc=false;
    if(t==0){ const float dl=rm; mhat+=dl;
      #pragma unroll
      for(int r=0;r<16;++r){a0[r]-=dl;a1[r]-=dl;b0[r]-=dl;b1[r]-=dl;}
      #pragma unroll
      for(int r=0;r<16;++r)negm[r]=-mhat; }
    else if(__any(rm>(float)THRL)){ const float dl=__builtin_fmaxf(rm,0.f); mhat+=dl;
      #pragma unroll
      for(int r=0;r<16;++r){a0[r]-=dl;a1[r]-=dl;b0[r]-=dl;b1[r]-=dl;}
      #pragma unroll
      for(int r=0;r<16;++r)negm[r]=-mhat;
      const float f=__builtin_amdgcn_exp2f(-dl); l_reg*=f; if(hi==0)wsf[r32]=f; resc=true; }
    if(resc){ asm volatile("s_waitcnt lgkmcnt(0)":::"memory");
      #pragma unroll
      for(int d_=0;d_<4;++d_)
        #pragma unroll
        for(int r=0;r<16;++r)o[d_][r]*=wsf[crow(r,hi)]; }
    float sacc=0.f,sacc2=0.f;
    #pragma unroll
    for(int r=0;r<16;++r){a0[r]=__builtin_amdgcn_exp2f(a0[r]);a1[r]=__builtin_amdgcn_exp2f(a1[r]);sacc+=a0[r]+a1[r];}
    #pragma unroll
    for(int r=0;r<16;++r){b0[r]=__builtin_amdgcn_exp2f(b0[r]);b1[r]=__builtin_amdgcn_exp2f(b1[r]);sacc2+=b0[r]+b1[r];}
    l_reg+=sacc+sacc2;
    #define PW4(P,B) (u32x4){cvtpk_s(P[B],P[B+1]),cvtpk_s(P[B+2],P[B+3]),cvtpk_s(P[B+4],P[B+5]),cvtpk_s(P[B+6],P[B+7])}
    { const u32x4 w0=PW4(a0,0),w1=PW4(a0,8),w2=PW4(a1,0),w3=PW4(a1,8);
      pv4(o,vb0+sl*B128_VS,__builtin_bit_cast(bf16x8,w0),__builtin_bit_cast(bf16x8,w1),__builtin_bit_cast(bf16x8,w2),__builtin_bit_cast(bf16x8,w3)); }
    { const u32x4 w0=PW4(b0,0),w1=PW4(b0,8),w2=PW4(b1,0),w3=PW4(b1,8);
      pv4(o,vb0+sl*B128_VS+16384,__builtin_bit_cast(bf16x8,w0),__builtin_bit_cast(bf16x8,w1),__builtin_bit_cast(bf16x8,w2),__builtin_bit_cast(bf16x8,w3)); }
    #undef PW4
  }
  {auto rr=__builtin_amdgcn_permlane32_swap(__float_as_uint(l_reg),__float_as_uint(l_reg),false,false);l_reg=__uint_as_float(rr[0])+__uint_as_float(rr[1]);}
  if(hi==0)wsf[32+r32]=l_reg;asm volatile("s_waitcnt lgkmcnt(0)":::"memory");
  float rli[16];
  #pragma unroll
  for(int r=0;r<16;++r)rli[r]=__builtin_amdgcn_rcpf(wsf[32+crow(r,hi)]);
  bf16*Ow=O+(rowbase+q0+wid*QBLK)*DM+vcol;
  _Float16*stg=(_Float16*)(shm+B128_V+(NS&1)*B128_VS)+wid*2048;
  #pragma unroll
  for(int dh=0;dh<2;++dh){
    #pragma unroll
    for(int r=0;r<16;++r){const int orow=crow(r,hi);
      #pragma unroll
      for(int d0=0;d0<2;++d0)stg[orow*64+d0*32+r32]=(_Float16)(o[dh*2+d0][r]*rli[r]);}
    asm volatile("s_waitcnt lgkmcnt(0)":::"memory");
    #pragma unroll
    for(int i=0;i<4;++i){const int row=i*8+(lane>>3),ch=lane&7; const u32x4 v=*(const u32x4*)(stg+row*64+ch*8); ATTN_STORE16(Ow+(long)row*DM+dh*64+ch*8,v);}
    asm volatile("s_waitcnt lgkmcnt(0)":::"memory");
  }
  asm volatile("s_waitcnt lgkmcnt(0)\n\ts_barrier":::"memory");
  #undef DMA_S
}
#undef SBAR
#undef WAIT_BAR
}
#define LAS __attribute__((address_space(3)))
typedef unsigned short bf16;
typedef unsigned v4u __attribute__((ext_vector_type(4)));
typedef unsigned v2u __attribute__((ext_vector_type(2)));
typedef float f32x4 __attribute__((ext_vector_type(4)));
typedef float f32x16 __attribute__((ext_vector_type(16)));
typedef short bf16x8 __attribute__((ext_vector_type(8)));
typedef short s16x4 __attribute__((ext_vector_type(4)));
typedef _Float16 h16x2 __attribute__((ext_vector_type(2)));

constexpr int NWAVES = 8, NTHR = 512;
constexpr int BATCH = 16, SEQ = 4096, D = 1024, FF = 2816, TOK = BATCH * SEQ;
constexpr int LDS_BYTES = 147456;
constexpr size_t MiB = 1u << 20;
constexpr size_t WS_LB = 0;
constexpr size_t WS_BAR = 65536, BAR_BYTES = 16384;
constexpr int LDS_MISC = 131072;
constexpr size_t WS_RS = 262144;
constexpr size_t WS_CS = 1 * MiB;
constexpr size_t WS_SS = 17 * MiB;
constexpr size_t SS_SLOT = (size_t)TOK * 16;
constexpr size_t WS_W = 25 * MiB;
constexpr size_t WS_XN = 128 * MiB;
constexpr size_t WS_P = 256 * MiB;
constexpr size_t WS_O0 = 768 * MiB, WS_O1 = 896 * MiB;
constexpr size_t WS_END = 1024 * MiB;
constexpr size_t W_AIN = 0, W_AOUT = W_AIN + 2ull * 3072 * 1024, W_HIN = W_AOUT + 2ull * 1024 * 1024, W_HOUT = W_HIN + 2ull * 4096 * 1024,
                 W_FIN = W_HOUT + 2ull * 1024 * 1024, W_FOUT = W_FIN + 4ull * 5632 * 1024, W_ENDE = W_FOUT + 4ull * 1024 * 2816;
static_assert(WS_W + W_ENDE * 2 <= WS_XN, "weights fit");

__device__ const double INVF[32] = {1.0, 0.7498942093324559, 0.5623413251903491, 0.4216965034285822, 0.31622776601683794, 0.23713737056616552, 0.1778279410038923, 0.1333521432163324, 0.1, 0.07498942093324558, 0.05623413251903491, 0.042169650342858224, 0.03162277660168379, 0.023713737056616554, 0.01778279410038923, 0.01333521432163324, 0.01, 0.007498942093324558, 0.005623413251903491, 0.004216965034285823, 0.0031622776601683794, 0.0023713737056616554, 0.0017782794100389228, 0.001333521432163324, 0.001, 0.0007498942093324559, 0.0005623413251903491, 0.00042169650342858224, 0.00031622776601683794, 0.00023713737056616554, 0.00017782794100389227, 0.0001333521432163324};

struct Params { const float* in[18]; float* out; unsigned char* ws; int ph_lo, ph_hi; };

#define LBAR() asm volatile("s_waitcnt lgkmcnt(0)\n\ts_barrier" ::: "memory")
typedef float f32x2_c __attribute__((ext_vector_type(2))); typedef __bf16 bf16x2_c __attribute__((ext_vector_type(2)));
__device__ __forceinline__ unsigned pk2(float lo, float hi) { f32x2_c v = {lo, hi}; bf16x2_c b = __builtin_convertvector(v, bf16x2_c); return __builtin_bit_cast(unsigned, b); }
__device__ __forceinline__ unsigned f2bf(float f) { return pk2(f, 0.f) & 0xffffu; }
__device__ __forceinline__ float bf_lo(unsigned w) { return __builtin_bit_cast(float, w << 16); }
__device__ __forceinline__ float bf_hi(unsigned w) { return __builtin_bit_cast(float, w & 0xffff0000u); }
__device__ __forceinline__ float h_lo(unsigned w) { h16x2 v = __builtin_bit_cast(h16x2, w); return (float)v[0]; }
__device__ __forceinline__ float h_hi(unsigned w) { h16x2 v = __builtin_bit_cast(h16x2, w); return (float)v[1]; }
__device__ __forceinline__ int crow(int r, int hi) { return (r & 3) + 8 * (r >> 2) + 4 * hi; }

#define XB_TMO      128
#define XB_XCNT(j)  (256  + 64 * (j))
#define XB_XSUB(j)  (1280 + 64 * (j))
#define XB_XGEN(j)  (2304 + 64 * (j))
#define XB_TOP      3328
#define XB_TOPGEN   3392
#define XCD_BAR_WORDS 3456
#define XB_SPIN_CAP (1u << 18)

__device__ __forceinline__ unsigned xb_ld(unsigned* p)              { return __hip_atomic_load(p, __ATOMIC_RELAXED, __HIP_MEMORY_SCOPE_AGENT); }
__device__ __forceinline__ unsigned xb_add(unsigned* p, unsigned v) { return __hip_atomic_fetch_add(p, v, __ATOMIC_RELAXED, __HIP_MEMORY_SCOPE_AGENT); }
__device__ __forceinline__ unsigned xb_xcc_id() { return (unsigned)__builtin_amdgcn_s_getreg((3 << 11) | 20) & 0xFu; }
#define XB_SPIN(cond, bar) do { unsigned _sp = 0; while (cond) { __builtin_amdgcn_s_sleep(1); \
    if ((++_sp & 255u) == 0u) { if (xb_ld(&(bar)[XB_TMO])) break; if (_sp > XB_SPIN_CAP) { atomicAdd(&(bar)[XB_TMO], 1u); break; } } } } while (0)

struct XcdBarrier {
    unsigned* bar; unsigned x;
    volatile LAS unsigned* st;
};

__device__ __forceinline__ XcdBarrier xcd_barrier_post(unsigned* bar, volatile LAS unsigned* st) {
    XcdBarrier b; b.bar = bar; b.x = xb_xcc_id(); b.st = st;
    if (threadIdx.x == 0) (void)xb_add(&bar[XB_XCNT(b.x)], 1u);
    return b;
}
__device__ __forceinline__ void xcd_barrier_complete(unsigned* bar, unsigned x, unsigned& nloc, unsigned& nx) {
    const unsigned G = gridDim.x * gridDim.y * gridDim.z;
    unsigned sum, cnt, mine, sp = 0u;
    for (;;) {
        sum = 0u; cnt = 0u; mine = 0u;
#pragma unroll
        for (unsigned j = 0; j < 16; ++j) { const unsigned c = xb_ld(&bar[XB_XCNT(j)]); sum += c; cnt += (c > 0u) ? 1u : 0u; mine = (j == x) ? c : mine; }
        if (sum == G) break;
        __builtin_amdgcn_s_sleep(1);
        if ((++sp & 255u) == 0u) { if (xb_ld(&bar[XB_TMO])) break; if (sp > XB_SPIN_CAP) { atomicAdd(&bar[XB_TMO], 1u); break; } }
    }
    nloc = mine > 0u ? mine : 1u; nx = cnt > 0u ? cnt : 1u;
}

__device__ __forceinline__ void xcd_barrier(const XcdBarrier& b) {
    asm volatile("s_waitcnt vmcnt(0)" ::: "memory");
    __syncthreads();
    if (threadIdx.x == 0) {
        unsigned* bar = b.bar;
        __builtin_amdgcn_s_waitcnt(0);
        unsigned nloc = b.st[0], nx = b.st[1];
        if (nloc == 0u) { xcd_barrier_complete(bar, b.x, nloc, nx); b.st[0] = nloc; b.st[1] = nx; }
        const unsigned old = xb_add(&bar[XB_XSUB(b.x)], 1u);
        const unsigned gen = old / nloc;
        if (old + 1u == (gen + 1u) * nloc) {
            __builtin_amdgcn_fence(__ATOMIC_RELEASE, "agent");
            asm volatile("s_waitcnt vmcnt(0)" ::: "memory");
            const unsigned og = xb_add(&bar[XB_TOP], 1u);
            const unsigned tg = og / nx;
            if (og + 1u == (tg + 1u) * nx) xb_add(&bar[XB_TOPGEN], 1u);
            else XB_SPIN(xb_ld(&bar[XB_TOPGEN]) == tg, bar);
            __builtin_amdgcn_fence(__ATOMIC_ACQUIRE, "agent");
            xb_add(&bar[XB_XGEN(b.x)], 1u);
            asm volatile("s_waitcnt vmcnt(0)" ::: "memory");
        } else {
            XB_SPIN(xb_ld(&bar[XB_XGEN(b.x)]) == gen, bar);
            __builtin_amdgcn_fence(__ATOMIC_ACQUIRE, "agent");
            asm volatile("s_waitcnt vmcnt(0)" ::: "memory");
        }
    }
    __syncthreads();
}

__device__ __forceinline__ int srccol(int mode, int vc) {
    if (mode == 1) { if (vc < 2048) { const int w = vc & 63; return (vc & ~63) + (w >> 1) + 32 * (w & 1); } return vc; }
    if (mode == 2) return (vc & 1) * FF + (vc >> 1);
    return vc;
}
__device__ __forceinline__ void conv_matrix(const float* W, int K, int N, bf16* WT, int mode, const float* nw, LAS float* scr, int gw, int ngw, int lane) {
    const int nblk = N / 32, nitems = (K / 64) * nblk;
    const int c4 = lane & 7, kr = lane >> 3;
    for (int item = gw; item < nitems; item += ngw) {
        const int kb = item / nblk, nb = item % nblk, k0 = 64 * kb, n0 = 32 * nb;
        const bool inter = (mode == 1 && n0 < 2048);
        int sc, vl0, vst;
        if (inter) { const int e = c4 >> 2, i0 = 4 * (c4 & 3);
            sc = (n0 & ~63) + ((n0 & 63) >> 1) + 32 * e + i0;
            vl0 = 2 * i0 + e; vst = 2; }
        else { sc = ((mode == 2) ? ((n0 >> 7) & 1) * FF + 128 * (n0 >> 8) + (n0 & 127) : n0) + 4 * c4; vl0 = 4 * c4; vst = 1; }
#pragma unroll
        for (int i = 0; i < 8; ++i) { const int kk = kr + 8 * i; f32x4 v = *(const f32x4*)(W + (size_t)(k0 + kk) * N + sc); if (nw) v = v * nw[k0 + kk];
            LAS float* d = scr + kk * 33 + vl0; d[0] = v.x; d[vst] = v.y; d[2 * vst] = v.z; d[3 * vst] = v.w; }
        asm volatile("s_waitcnt lgkmcnt(0)" ::: "memory");
        const int c = lane & 7;
#pragma unroll
        for (int j = 0; j < 4; ++j) { const int n = (lane >> 3) + 8 * j; const LAS float* s = scr + (8 * c) * 33 + n;
            v4u o; o.x = pk2(s[0 * 33], s[1 * 33]); o.y = pk2(s[2 * 33], s[3 * 33]); o.z = pk2(s[4 * 33], s[5 * 33]); o.w = pk2(s[6 * 33], s[7 * 33]);
            *(v4u*)(WT + (size_t)(n0 + n) * K + k0 + 8 * c) = o; }
        asm volatile("s_waitcnt lgkmcnt(0)" ::: "memory");
    }
}
__device__ __forceinline__ float wave_sum(float v) {
#pragma unroll
    for (int o = 1; o < 64; o <<= 1) v += __shfl_xor(v, o);
    return v;
}
__device__ __forceinline__ void p0_prologue(const Params& p, LAS unsigned char* lds, int vcu, int G) {
    const int tid = mk_tid(), lane = tid & 63, wave = __builtin_amdgcn_readfirstlane(tid >> 6);
    LAS float* scr = (LAS float*)(lds + wave * 16384);
    const int gw = vcu * NWAVES + wave, ngw = G * NWAVES;
    unsigned char* ws = p.ws;
    bf16* WB = (bf16*)(ws + WS_W);
    for (int j = 0; j < 2; ++j) {
        conv_matrix(p.in[5] + (size_t)j * D * 3 * D, D, 3 * D, WB + W_AIN + (size_t)j * 3 * D * D, 1, p.in[2] + (2 * j) * D, scr, gw, ngw, lane);
        conv_matrix(p.in[6] + (size_t)j * D * D, D, D, WB + W_AOUT + (size_t)j * D * D, 0, nullptr, scr, gw, ngw, lane);
        conv_matrix(p.in[12] + (size_t)j * D * 4 * D, D, 4 * D, WB + W_HIN + (size_t)j * 4 * D * D, 0, p.in[2] + (2 * j + 1) * D, scr, gw, ngw, lane);
        conv_matrix(p.in[13] + (size_t)j * D * D, D, D, WB + W_HOUT + (size_t)j * D * D, 0, nullptr, scr, gw, ngw, lane);
    }
    for (int l = 0; l < 4; ++l) {
        conv_matrix(p.in[16] + (size_t)l * D * 2 * FF, D, 2 * FF, WB + W_FIN + (size_t)l * 2 * FF * D, 2, p.in[3] + l * D, scr, gw, ngw, lane);
        conv_matrix(p.in[17] + (size_t)l * FF * D, FF, D, WB + W_FOUT + (size_t)l * D * FF, 0, nullptr, scr, gw, ngw, lane);
    }
    { const float* x = p.in[0]; bf16* XN = (bf16*)(ws + WS_XN); float* ss0 = (float*)(ws + WS_SS);
      for (int m = gw; m < TOK; m += ngw) {
          const f32x4* xr = (const f32x4*)(x + (size_t)m * D) + lane; f32x4 v[4]; float s = 0.f;
#pragma unroll
          for (int j = 0; j < 4; ++j) { v[j] = xr[64 * j]; s += (v[j].x * v[j].x + v[j].y * v[j].y) + (v[j].z * v[j].z + v[j].w * v[j].w); }
          s = wave_sum(s);
          v2u* o8 = (v2u*)(XN + (size_t)m * D) + lane;
#pragma unroll
          for (int j = 0; j < 4; ++j) { v2u w; w.x = pk2(v[j].x, v[j].y); w.y = pk2(v[j].z, v[j].w); o8[64 * j] = w; }
          if (lane < 16) ss0[(size_t)m * 16 + lane] = (lane == 0) ? s : 0.f;
      } }
    { const int* pos = (const int*)p.in[1]; float* cs = (float*)(ws + WS_CS); const int gt = vcu * NTHR + tid, ngt = G * NTHR;
      for (int idx = gt; idx < TOK * 32; idx += ngt) {
          const int t = idx >> 5, i = idx & 31;
          const double a = (double)pos[t] * INVF[i];
          const double k = __builtin_rint(a * 0.15915494309189535);
          double r = __builtin_fma(-k, 6.283185307179586, a); r = __builtin_fma(-k, 2.4492935982947064e-16, r);
          const float rf = (float)r;
          cs[2 * (size_t)idx] = cosf(rf); cs[2 * (size_t)idx + 1] = sinf(rf);
      } }
    if (vcu == 0) {
        float* LB = (float*)(ws + WS_LB);
        for (int c = tid; c < D; c += NTHR) {
            const float* lp = p.in[15]; const float a0 = lp[c], a1 = lp[D + c], a2 = lp[2 * D + c], a3 = lp[3 * D + c];
            const float mx = fmaxf(fmaxf(a0, a1), fmaxf(a2, a3));
            const float e0 = expf(a0 - mx), e1 = expf(a1 - mx), e2 = expf(a2 - mx), e3 = expf(a3 - mx), inv = 1.0f / (e0 + e1 + e2 + e3);
            LB[c] = e1 * inv; LB[D + c] = (e1 + e2 + e3) * inv;
        }
        if (wave == 0) {
            for (int j = 0; j < 2; ++j) {
                const float s1 = wave_sum(p.in[7][j * 64 + lane] * p.in[8][j * 64 + lane]), s2 = wave_sum(p.in[9][j * 64 + lane] * p.in[10][j * 64 + lane]);
                const float li = (j == 0) ? 0.2f : 0.47071301834358416f;
                if (lane == 0) LB[2 * D + j] = expf(s1) - expf(s2) + li;
            }
        }
    }
}

__device__ __forceinline__ void combine_phase(const unsigned short* O0, const unsigned short* O1, bf16* out, const float* subw, float lam, float post, int vcu, int G) {
    const int tid = mk_tid(), lane = tid & 63, gw = vcu * NWAVES + __builtin_amdgcn_readfirstlane(tid >> 6), ngw = G * NWAVES;
    f32x4 w4[4];
#pragma unroll
    for (int j = 0; j < 4; ++j) w4[j] = *(const f32x4*)(subw + ((16 * lane) & 127) + 4 * j);
    for (int m = gw; m < TOK; m += ngw) {
        const v4u* a = (const v4u*)(O0 + (size_t)m * D + 16 * lane); const v4u* b = (const v4u*)(O1 + (size_t)m * D + 16 * lane);
        const v4u a0 = a[0], a1 = a[1], b0 = b[0], b1 = b[1];
        float d[16];
#pragma unroll
        for (int j = 0; j < 4; ++j) { d[2 * j] = h_lo(a0[j]) - lam * h_lo(b0[j]); d[2 * j + 1] = h_hi(a0[j]) - lam * h_hi(b0[j]);
                                      d[8 + 2 * j] = h_lo(a1[j]) - lam * h_lo(b1[j]); d[9 + 2 * j] = h_hi(a1[j]) - lam * h_hi(b1[j]); }
        float s = 0.f;
#pragma unroll
        for (int j = 0; j < 16; ++j) s += d[j] * d[j];
        s += __shfl_xor(s, 1); s += __shfl_xor(s, 2); s += __shfl_xor(s, 4);
        const float rn = rsqrtf(s * (1.0f / 128.0f) + 1e-5f) * post;
        v4u o0, o1;
#pragma unroll
        for (int j = 0; j < 4; ++j) { o0[j] = pk2(d[2 * j] * rn * w4[j >> 1][2 * (j & 1)], d[2 * j + 1] * rn * w4[j >> 1][2 * (j & 1) + 1]);
                                      o1[j] = pk2(d[8 + 2 * j] * rn * w4[2 + (j >> 1)][2 * (j & 1)], d[9 + 2 * j] * rn * w4[2 + (j >> 1)][2 * (j & 1) + 1]); }
        v4u* op = (v4u*)(out + (size_t)m * D + 16 * lane); op[0] = o0; op[1] = o1;
    }
}
__device__ __forceinline__ void combine_block(const unsigned short* O0, const unsigned short* O1, bf16* out, const float* subw, float lam, float post, size_t row0, int col0) {
    const int tid = mk_tid(), lane = tid & 63, wid = __builtin_amdgcn_readfirstlane(tid >> 6);
    const int seg = lane & 7;
    f32x4 w4[4];
#pragma unroll
    for (int j = 0; j < 4; ++j) w4[j] = *(const f32x4*)(subw + 16 * seg + 4 * j);
#pragma unroll
    for (int step = 0; step < 4; ++step) {
        const size_t m = row0 + wid * 32 + step * 8 + (lane >> 3);
        const v4u* a = (const v4u*)(O0 + m * D + col0 + 16 * seg); const v4u* b = (const v4u*)(O1 + m * D + col0 + 16 * seg);
        const v4u a0 = a[0], a1 = a[1], b0 = b[0], b1 = b[1];
        float d[16];
#pragma unroll
        for (int j = 0; j < 4; ++j) { d[2 * j] = h_lo(a0[j]) - lam * h_lo(b0[j]); d[2 * j + 1] = h_hi(a0[j]) - lam * h_hi(b0[j]);
                                      d[8 + 2 * j] = h_lo(a1[j]) - lam * h_lo(b1[j]); d[9 + 2 * j] = h_hi(a1[j]) - lam * h_hi(b1[j]); }
        float s = 0.f;
#pragma unroll
        for (int j = 0; j < 16; ++j) s += d[j] * d[j];
        s += __shfl_xor(s, 1); s += __shfl_xor(s, 2); s += __shfl_xor(s, 4);
        const float rn = rsqrtf(s * (1.0f / 128.0f) + 1e-5f) * post;
        v4u o0, o1;
#pragma unroll
        for (int j = 0; j < 4; ++j) { o0[j] = pk2(d[2 * j] * rn * w4[j >> 1][2 * (j & 1)], d[2 * j + 1] * rn * w4[j >> 1][2 * (j & 1) + 1]);
                                      o1[j] = pk2(d[8 + 2 * j] * rn * w4[2 + (j >> 1)][2 * (j & 1)], d[9 + 2 * j] * rn * w4[2 + (j >> 1)][2 * (j & 1) + 1]); }
        v4u* op = (v4u*)(out + m * D + col0 + 16 * seg); op[0] = o0; op[1] = o1;
    }
}
__device__ __forceinline__ void gnorm_phase(bf16* O, const bf16* Gt, const float* gw_, int vcu, int G) {
    const int tid = mk_tid(), lane = tid & 63, gw = vcu * NWAVES + __builtin_amdgcn_readfirstlane(tid >> 6), ngw = G * NWAVES;
    f32x4 w4[4];
#pragma unroll
    for (int j = 0; j < 4; ++j) w4[j] = *(const f32x4*)(gw_ + ((16 * lane) & 127) + 4 * j);
    for (int m = gw; m < TOK; m += ngw) {
        v4u* a = (v4u*)(O + (size_t)m * D + 16 * lane); const v4u* b = (const v4u*)(Gt + (size_t)m * D + 16 * lane);
        const v4u a0 = a[0], a1 = a[1], b0 = b[0], b1 = b[1];
        float d[16], g[16];
#pragma unroll
        for (int j = 0; j < 4; ++j) { d[2 * j] = bf_lo(a0[j]); d[2 * j + 1] = bf_hi(a0[j]); d[8 + 2 * j] = bf_lo(a1[j]); d[9 + 2 * j] = bf_hi(a1[j]);
                                      g[2 * j] = bf_lo(b0[j]); g[2 * j + 1] = bf_hi(b0[j]); g[8 + 2 * j] = bf_lo(b1[j]); g[9 + 2 * j] = bf_hi(b1[j]); }
        float s = 0.f;
#pragma unroll
        for (int j = 0; j < 16; ++j) s += d[j] * d[j];
        s += __shfl_xor(s, 1); s += __shfl_xor(s, 2); s += __shfl_xor(s, 4);
        const float rn = rsqrtf(s * (1.0f / 128.0f) + 1e-6f);
        v4u o0, o1;
#pragma unroll
        for (int j = 0; j < 4; ++j) { o0[j] = pk2(d[2 * j] * rn * w4[j >> 1][2 * (j & 1)] * g[2 * j], d[2 * j + 1] * rn * w4[j >> 1][2 * (j & 1) + 1] * g[2 * j + 1]);
                                      o1[j] = pk2(d[8 + 2 * j] * rn * w4[2 + (j >> 1)][2 * (j & 1)] * g[8 + 2 * j], d[9 + 2 * j] * rn * w4[2 + (j >> 1)][2 * (j & 1) + 1] * g[9 + 2 * j]); }
        a[0] = o0; a[1] = o1;
    }
}
__device__ __forceinline__ void final_phase(const bf16* X, float* out, const float* ss, const float* fw, int vcu, int G) {
    const int tid = mk_tid(), lane = tid & 63, gw = vcu * NWAVES + __builtin_amdgcn_readfirstlane(tid >> 6), ngw = G * NWAVES;
    f32x4 w4[4];
#pragma unroll
    for (int j = 0; j < 4; ++j) w4[j] = *(const f32x4*)(fw + 16 * lane + 4 * j);
    for (int m = gw; m < TOK; m += ngw) {
        const float rs = pg8::row_rstd(ss, m, 1e-6f);
        const v4u* a = (const v4u*)(X + (size_t)m * D + 16 * lane); const v4u a0 = a[0], a1 = a[1];
        f32x4* op = (f32x4*)(out + (size_t)m * D + 16 * lane);
        op[0] = (f32x4){bf_lo(a0.x), bf_hi(a0.x), bf_lo(a0.y), bf_hi(a0.y)} * rs * w4[0];
        op[1] = (f32x4){bf_lo(a0.z), bf_hi(a0.z), bf_lo(a0.w), bf_hi(a0.w)} * rs * w4[1];
        op[2] = (f32x4){bf_lo(a1.x), bf_hi(a1.x), bf_lo(a1.y), bf_hi(a1.y)} * rs * w4[2];
        op[3] = (f32x4){bf_lo(a1.z), bf_hi(a1.z), bf_lo(a1.w), bf_hi(a1.w)} * rs * w4[3];
    }
}
constexpr int SC_QDT = 0, SC_KDT = 8192, SC_KET = 16384, SC_VT = 26624, SC_VTB = 5120, SC_DEC = 36864, SC_OP = 37376, SC_END = 53760;
constexpr int KTP = 40;
__device__ __forceinline__ void scan_item(LAS unsigned char* lds, const bf16* Pq, const unsigned short* Plf, const bf16* Pv, bf16* Oo, int item) {
    typedef __attribute__((address_space(3))) const char* lcp;
    const int tid = mk_tid(), lane = tid & 63, wid = __builtin_amdgcn_readfirstlane(tid >> 6);
    const int bh = item >> 1, vs = item & 1, b = bh >> 3, h = bh & 7;
    const size_t row0 = (size_t)b * SEQ;
    LAS unsigned short* QDT = (LAS unsigned short*)(lds + SC_QDT); LAS unsigned short* KDT = (LAS unsigned short*)(lds + SC_KDT);
    LAS unsigned short* KET = (LAS unsigned short*)(lds + SC_KET); LAS unsigned short* VT0 = (LAS unsigned short*)(lds + SC_VT);
    LAS float* DEC = (LAS float*)(lds + SC_DEC); LAS unsigned* OPH = (LAS unsigned*)(lds + SC_OP);
    const int ch = 16 * wid + (lane & 15), tg = lane >> 4;
    const int n32 = lane & 31, hi = lane >> 5, kb = wid >> 1, vb = wid & 1;
    const unsigned short* gq = (const unsigned short*)Pq + (row0 + tg * 8) * D + h * 128 + ch;
    const unsigned short* gl = Plf + (row0 + tg * 8) * D + h * 128 + ch;
    const int vtok = tid & 31, vcg = (tid >> 5) & 7;
    const v4u* gv = (const v4u*)(Pv + (row0 + vtok) * D + h * 128 + vs * 64 + vcg * 8);
    constexpr size_t CSTEP = (size_t)32 * D * 2 / 16, CEL = (size_t)32 * D;
    unsigned rq[8], rl[8]; v4u rv = (v4u){0u, 0u, 0u, 0u};
#pragma unroll
    for (int i = 0; i < 8; ++i) { rq[i] = gq[(size_t)i * D]; rl[i] = gl[(size_t)i * D]; }
    if (tid < 256) rv = gv[0];
    const int troff = ((lane >> 4) & 1) * 32 + (lane & 3) * 8 + (4 * hi + ((lane & 15) >> 2)) * 64;
    f32x16 st;
#pragma unroll
    for (int r = 0; r < 16; ++r) st[r] = 0.f;
    constexpr int NCH = SEQ / 32;
    const int otok = tid & 31, ovq = tid >> 5, ovbb = ovq >> 3, ovl0 = (ovq & 7) * 4;
    bf16* ogp = Oo + (row0 + otok) * D + h * 128 + vs * 64 + ovq * 4;
#define SC_STORE_O(nn) do { float o_[4]; _Pragma("unroll") for (int j = 0; j < 2; ++j) { const int a_ = ovbb * 512 + ((ovl0 >> 1) + j) * 32 + otok; const unsigned w0_ = OPH[a_], w1_ = OPH[a_ + 1024], w2_ = OPH[a_ + 2048], w3_ = OPH[a_ + 3072]; \
        o_[2 * j] = (bf_lo(w0_) + bf_lo(w1_)) + (bf_lo(w2_) + bf_lo(w3_)); o_[2 * j + 1] = (bf_hi(w0_) + bf_hi(w1_)) + (bf_hi(w2_) + bf_hi(w3_)); } \
        v2u w_; w_.x = pk2(o_[0], o_[1]); w_.y = pk2(o_[2], o_[3]); *(v2u*)(ogp + (size_t)(nn) * 32 * D) = w_; } while (0)
#define SC_TRF(base) ({ const s16x4 lo_ = attn_body::vtr((lcp)(base) + troff), hi_ = attn_body::vtr((lcp)(base) + troff + 512); (bf16x8){lo_[0], lo_[1], lo_[2], lo_[3], hi_[0], hi_[1], hi_[2], hi_[3]}; })
    for (int n = 0; n < NCH; ++n) {
        LAS unsigned short* VT = VT0 + (n & 1) * (SC_VTB / 2);
        {
            float f[8]; float tsum = 0.f;
#pragma unroll
            for (int i = 0; i < 8; ++i) { const float l = h_lo(rl[i]); tsum += l; f[i] = __expf(l); }
            const float t0 = __shfl(tsum, lane & 15), t1 = __shfl(tsum, (lane & 15) + 16), t2 = __shfl(tsum, (lane & 15) + 32), t3 = __shfl(tsum, (lane & 15) + 48);
            const float off = (tg > 0 ? t0 : 0.f) + (tg > 1 ? t1 : 0.f) + (tg > 2 ? t2 : 0.f);
            const float blast = (t0 + t1) + (t2 + t3);
            const float eb = __expf(blast);
            float e = __expf(off), qd[8], kd[8], ke[8];
#pragma unroll
            for (int i = 0; i < 8; ++i) {
                e *= f[i];
                const float inv = __builtin_amdgcn_rcpf(e);
                const float k = 1.0f - f[i];
                qd[i] = bf_lo(rq[i]) * e; kd[i] = k * inv; ke[i] = k * (eb * inv);
            }
            v4u w;
            w.x = pk2(qd[0], qd[1]); w.y = pk2(qd[2], qd[3]); w.z = pk2(qd[4], qd[5]); w.w = pk2(qd[6], qd[7]); *(LAS v4u*)(QDT + ch * 32 + tg * 8) = w;
            w.x = pk2(kd[0], kd[1]); w.y = pk2(kd[2], kd[3]); w.z = pk2(kd[4], kd[5]); w.w = pk2(kd[6], kd[7]); *(LAS v4u*)(KDT + ch * 32 + tg * 8) = w;
            w.x = pk2(ke[0], ke[1]); w.y = pk2(ke[2], ke[3]); w.z = pk2(ke[4], ke[5]); w.w = pk2(ke[6], ke[7]); *(LAS v4u*)(KET + ch * KTP + tg * 8) = w;
            if (tg == 0) DEC[ch] = eb;
        }
        if (tid < 256) {
#pragma unroll
            for (int j = 0; j < 4; ++j) { VT[(vcg * 8 + 2 * j) * KTP + vtok] = (unsigned short)(rv[j] & 0xffffu); VT[(vcg * 8 + 2 * j + 1) * KTP + vtok] = (unsigned short)(rv[j] >> 16); }
        }
        if (n + 1 < NCH) {
#pragma unroll
            for (int i = 0; i < 8; ++i) { rq[i] = gq[(size_t)(n + 1) * CEL + (size_t)i * D]; rl[i] = gl[(size_t)(n + 1) * CEL + (size_t)i * D]; }
            if (tid < 256) rv = gv[(size_t)(n + 1) * CSTEP];
        }
        if (n > 0) SC_STORE_O(n - 1);
        LBAR();
        {
            f32x16 sT;
#pragma unroll
            for (int r = 0; r < 16; ++r) sT[r] = 0.f;
#pragma unroll
            for (int s = 0; s < 2; ++s) {
                const bf16x8 a = SC_TRF(KDT + (kb * 2 + s) * 512);
                const bf16x8 bq = SC_TRF(QDT + (kb * 2 + s) * 512);
                sT = __builtin_amdgcn_mfma_f32_32x32x16_bf16(a, bq, sT, 0, 0, 0);
            }
#pragma unroll
            for (int r = 0; r < 16; ++r) { if (crow(r, hi) > n32) sT[r] = 0.f; }
            f32x16 oT;
#pragma unroll
            for (int r = 0; r < 16; ++r) oT[r] = 0.f;
#pragma unroll
            for (int s = 0; s < 2; ++s) {
                v4u bsw; bsw.x = pk2(sT[8 * s + 0], sT[8 * s + 1]); bsw.y = pk2(sT[8 * s + 2], sT[8 * s + 3]); bsw.z = pk2(sT[8 * s + 4], sT[8 * s + 5]); bsw.w = pk2(sT[8 * s + 6], sT[8 * s + 7]);
                const v2u vlo = *(const LAS v2u*)(VT + (vb * 32 + n32) * KTP + 16 * s + 4 * hi), vhi = *(const LAS v2u*)(VT + (vb * 32 + n32) * KTP + 16 * s + 8 + 4 * hi);
                const v4u avw = {vlo.x, vlo.y, vhi.x, vhi.y};
                oT = __builtin_amdgcn_mfma_f32_32x32x16_bf16(__builtin_bit_cast(bf16x8, avw), __builtin_bit_cast(bf16x8, bsw), oT, 0, 0, 0);
                v4u asw; asw.x = pk2(st[8 * s + 0], st[8 * s + 1]); asw.y = pk2(st[8 * s + 2], st[8 * s + 3]); asw.z = pk2(st[8 * s + 4], st[8 * s + 5]); asw.w = pk2(st[8 * s + 6], st[8 * s + 7]);
                const bf16x8 bqp = SC_TRF(QDT + (kb * 2 + s) * 512);
                oT = __builtin_amdgcn_mfma_f32_32x32x16_bf16(__builtin_bit_cast(bf16x8, asw), bqp, oT, 0, 0, 0);
            }
#pragma unroll
            for (int r = 0; r < 16; r += 2) OPH[wid * 512 + (crow(r, hi) >> 1) * 32 + n32] = pk2(oT[r], oT[r + 1]);
#pragma unroll
            for (int r = 0; r < 16; ++r) st[r] *= DEC[kb * 32 + crow(r, hi)];
#pragma unroll
            for (int s = 0; s < 2; ++s) {
                const bf16x8 a = *(const LAS bf16x8*)(KET + (kb * 32 + n32) * KTP + 16 * s + 8 * hi);
                const bf16x8 bv = *(const LAS bf16x8*)(VT + (vb * 32 + n32) * KTP + 16 * s + 8 * hi);
                st = __builtin_amdgcn_mfma_f32_32x32x16_bf16(a, bv, st, 0, 0, 0);
            }
        }
        LBAR();
    }
    SC_STORE_O(NCH - 1);
#undef SC_STORE_O
#undef SC_TRF
    LBAR();
}
constexpr int N_PHASES = 26;
__global__ void __launch_bounds__(NTHR, 2) mk_fwd(Params p) {
    extern __shared__ __attribute__((aligned(16))) unsigned char lds_raw[];
    cg::grid_group grid = cg::this_grid();
    LAS unsigned char* lds = (LAS unsigned char*)lds_raw;
    const int G = gridDim.x, bx = blockIdx.x;
    const int vcu = (G % 8 == 0) ? (bx % 8) * (G / 8) + bx / 8 : bx;
    unsigned char* ws = p.ws;
    bf16* WB = (bf16*)(ws + WS_W); bf16* XN = (bf16*)(ws + WS_XN); bf16* P0 = (bf16*)(ws + WS_P);
    bf16* O0 = (bf16*)(ws + WS_O0); bf16* O1 = (bf16*)(ws + WS_O1);
    float* SS = (float*)(ws + WS_SS); const float* LB = (const float*)(ws + WS_LB); const float* CS = (const float*)(ws + WS_CS);
    const int lo = p.ph_lo, hi = p.ph_hi;
#define IN(k) (lo <= (k) && (k) < hi)
#define SEAM(k) do { if (IN(k) && IN((k) + 1)) { if ((k) == 0) grid.sync(); else xcd_barrier(bar); } } while (0)
    { const int t0 = mk_tid(); if (t0 < 64) ((LAS unsigned*)(lds + LDS_MISC))[t0] = 0u; __syncthreads(); }
    XcdBarrier bar = xcd_barrier_post((unsigned*)(ws + WS_BAR), (volatile LAS unsigned*)(lds + LDS_MISC) + 8);
#ifndef SKIP_P0
    if (IN(0)) p0_prologue(p, lds, vcu, G);
#endif
    SEAM(0);
    LAS unsigned char* RSL = lds + LDS_MISC + 256;
#define RS_PREPASS(S_) do { const int t_ = mk_tid(); pg8::Unit u_; int last_ = -1, ns_ = 0; for (int i_ = 0; (S_).next(i_, u_); ++i_) { if (u_.pm != last_) { last_ = u_.pm; \
        if (t_ < 256) ((LAS float*)(RSL + 256))[ns_ * 256 + t_] = pg8::row_rstd(ss_in, u_.pm * 256 + t_, 1e-6f); if (t_ == 0) RSL[u_.pm] = (unsigned char)ns_; ++ns_; } } \
        asm volatile("s_waitcnt vmcnt(0) lgkmcnt(0)" ::: "memory"); __syncthreads(); } while (0)
#pragma unroll 1
    for (int hl = 0; hl < 8; ++hl) {
        const int L = hl >> 1, pb = 1 + 6 * L, j = L >> 1;
        const float* ss_in = SS + (size_t)(hl & 1) * SS_SLOT; float* ss_out = SS + (size_t)((hl + 1) & 1) * SS_SLOT;
        const bf16* Aop; const bf16* Bop; int Kop, pg4;
        if ((hl & 1) == 0) {
            pg4 = pb + 3; Kop = D;
            if ((L & 1) == 0) {
                Aop = P0; Bop = WB + W_AOUT + (size_t)j * D * D;
#ifndef SKIP_G1
                if (IN(pb)) { pg8::Gemm g{XN, WB + W_AIN + (size_t)j * 3 * D * D, TOK, 3 * D, D}; pg8::StaticOrder S; S.init(TOK, 3 * D, G, bx);
                    RS_PREPASS(S); pg8::EpiQKV E{P0, RSL, CS};
                    pg8::gemm_phase<pg8::EpiQKV, pg8::StaticOrder, true, true>(lds, g, S, E); }
#endif
                SEAM(pb);
#ifndef SKIP_ATTN
                if (IN(pb + 1)) {
                    const attn_body::bf16* Q = (const attn_body::bf16*)P0; const attn_body::bf16* K = (const attn_body::bf16*)(P0 + pg8::TSTRIDE); const attn_body::bf16* V = (const attn_body::bf16*)(P0 + 2 * pg8::TSTRIDE);
#if MK_ATTN128
                    const int ngrp = G >> 3, grp = vcu >> 3, sq = vcu & 7, per = (BATCH * 16) / ngrp;
                    for (int it = 0; it < per; ++it) {
                        const int pu = grp * per + it, b = pu >> 4, uu = pu & 15, h = uu >> 1, c = uu & 1;
                        attn_body::bf16* O = (attn_body::bf16*)(c ? O1 : O0);
                        for (int half = 0; half < 2; ++half) {
                            const int qb = half ? sq : 15 - sq;
#if MK_ATTN_X2
                            attn_body::attn128x2_unit<8>(b, (h * 2 + c) * 64, h * 128, qb, Q, K, V, O, (char*)lds_raw);
#else
                            attn_body::attn128_unit<8>(b, (h * 2 + c) * 64, h * 128, qb, Q, K, V, O, (char*)lds_raw);
#endif
                        }
#if MK_FUSE_COMBINE
                        if (c == 1) {
                            asm volatile("s_waitcnt vmcnt(0)" ::: "memory"); __syncthreads();
                            for (int half = 0; half < 2; ++half)
                                combine_block((const unsigned short*)O0, (const unsigned short*)O1, P0, p.in[11] + j * 128, LB[2 * D + j], (j == 0) ? 0.8f : (1.0f - 0.47071301834358416f), (size_t)b * SEQ + (size_t)(half ? sq : 15 - sq) * 256, h * 128);
                        }
#endif
                    }
                }
#else
                    const int ngrp = G >> 3, grp = vcu >> 3, sq = vcu & 7, per = (BATCH * 32) / ngrp;
                    for (int it = 0; it < per; ++it) {
                        const int pu = grp * per + it, b = pu >> 5, uu = pu & 31, h = uu >> 2, c = (uu >> 1) & 1, vh = uu & 1;
                        attn_body::bf16* O = (attn_body::bf16*)(c ? O1 : O0);
                        for (int half = 0; half < 2; ++half) {
                            const int qb = half ? sq : 15 - sq;
                            attn_body::attn_unit<8>(b, (h * 2 + c) * 64, h * 128 + vh * 64, qb, Q, K, V, O, (char*)lds_raw);
                        }
                    }
                }
#endif
#endif
                SEAM(pb + 1);
#if !(MK_ATTN128 && MK_FUSE_COMBINE)
                if (IN(pb + 2)) combine_phase((const unsigned short*)O0, (const unsigned short*)O1, P0, p.in[11] + j * 128, LB[2 * D + j], (j == 0) ? 0.8f : (1.0f - 0.47071301834358416f), vcu, G);
                SEAM(pb + 2);
#endif
            } else {
                Aop = O0; Bop = WB + W_HOUT + (size_t)j * D * D;
#ifndef SKIP_G2
                if (IN(pb)) { pg8::Gemm g{XN, WB + W_HIN + (size_t)j * 4 * D * D, TOK, 4 * D, D}; pg8::StaticOrder S; S.init(TOK, 4 * D, G, bx);
                    RS_PREPASS(S); pg8::EpiHG E{P0, RSL, LB + j * D};
                    pg8::gemm_phase<pg8::EpiHG, pg8::StaticOrder, true, true>(lds, g, S, E); }
#endif
                SEAM(pb);
#ifndef SKIP_SCAN
                if (IN(pb + 1)) { for (int item = vcu; item < BATCH * 8 * 2; item += G) scan_item(lds, P0, (const unsigned short*)(P0 + pg8::TSTRIDE), P0 + 2 * pg8::TSTRIDE, O0, item); }
#endif
                SEAM(pb + 1);
                if (IN(pb + 2)) gnorm_phase(O0, P0 + 3 * pg8::TSTRIDE, p.in[14] + j * 128, vcu, G);
                SEAM(pb + 2);
            }
        } else {
            pg4 = pb + 5; Kop = FF; Aop = P0; Bop = WB + W_FOUT + (size_t)L * D * FF;
#ifndef SKIP_G3
            if (IN(pb + 4)) { pg8::Gemm g{XN, WB + W_FIN + (size_t)L * 2 * FF * D, TOK, 2 * FF, D}; pg8::StaticOrder S; S.init(TOK, 2 * FF, G, bx);
                RS_PREPASS(S); pg8::EpiFFN E{P0, RSL};
                pg8::gemm_phase<pg8::EpiFFN, pg8::StaticOrder, true, true>(lds, g, S, E); }
#endif
            SEAM(pb + 4);
        }
#ifndef SKIP_G4
        if (IN(pg4)) { pg8::Gemm g{Aop, Bop, TOK, D, Kop}; pg8::StaticOrder S; S.init(TOK, D, G, bx);
            pg8::EpiRes E{XN, ss_out};
            pg8::gemm_phase<pg8::EpiRes, pg8::StaticOrder, true, true>(lds, g, S, E); }
#endif
        SEAM(pg4);
    }
    if (IN(25)) final_phase(XN, p.out, SS, p.in[4], vcu, G);
#undef IN
#undef SEAM
}

extern "C" void kernel_launch(void* const* d_in, const int* in_sizes, int n_in, void* d_out, int out_size, void* d_ws, size_t ws_size, hipStream_t stream) {
    static int grid = 0;
    if (grid == 0) {
        if (n_in != 18 || out_size != TOK * D || ws_size < WS_END) { fprintf(stderr, "kernel_launch: unexpected shapes (n_in %d out %d ws %zu)\n", n_in, out_size, ws_size); grid = -1; return; }
        int dev = 0, cus = 0, per_cu = 0;
        hipGetDevice(&dev); hipDeviceGetAttribute(&cus, hipDeviceAttributeMultiprocessorCount, dev);
        if (hipFuncSetAttribute((const void*)mk_fwd, hipFuncAttributeMaxDynamicSharedMemorySize, LDS_BYTES) != hipSuccess) { fprintf(stderr, "kernel_launch: hipFuncSetAttribute failed\n"); grid = -1; return; }
        if (hipOccupancyMaxActiveBlocksPerMultiprocessor(&per_cu, (const void*)mk_fwd, NTHR, LDS_BYTES) != hipSuccess || per_cu < 1) { fprintf(stderr, "kernel_launch: occupancy query says %d\n", per_cu); per_cu = 1; }
        (void)hipGetLastError();
        grid = cus * 1;
        if (grid > 256) grid = 256;
    }
    if (grid < 0) return;
    (void)hipMemsetAsync((char*)d_ws + WS_BAR, 0, BAR_BYTES, stream);
    Params a{};
    for (int i = 0; i < 18; ++i) a.in[i] = (const float*)d_in[i];
    a.out = (float*)d_out; a.ws = (unsigned char*)d_ws;
#if MK_MULTI
    for (int ph = 0; ph < N_PHASES; ++ph) { a.ph_lo = ph; a.ph_hi = ph + 1; hipLaunchKernelGGL(mk_fwd, dim3(grid), dim3(NTHR), LDS_BYTES, stream, a); }
#else
    a.ph_lo = 0; a.ph_hi = N_PHASES;
    void* args[] = {&a};
    hipError_t e = hipLaunchCooperativeKernel((const void*)mk_fwd, dim3(grid), dim3(NTHR), args, LDS_BYTES, stream);
    if (e != hipSuccess) fprintf(stderr, "cooperative launch failed: %s (grid %d)\n", hipGetErrorString(e), grid);
#endif
}
```

```cpp
#include <hip/hip_runtime.h>
#include <hip/hip_bf16.h>
#include <hip/hip_cooperative_groups.h>
#include <cstdio>
#include <cstdint>
namespace cg = cooperative_groups;
#ifndef MK_ATTN128
#define MK_ATTN128 1
#endif
#ifndef MK_FUSE_COMBINE
#define MK_FUSE_COMBINE 1
#endif
#ifndef MK_ATTN_X2
#define MK_ATTN_X2 1
#endif
#ifndef MK_MULTI
#define MK_MULTI 0
#endif
__device__ __forceinline__ int mk_tid() { int t = threadIdx.x; asm volatile("" : "+v"(t)); return t; }
namespace pg8 {
#define PG8_LAS __attribute__((address_space(3)))
typedef unsigned short bf16_t;
typedef short bf16x8 __attribute__((ext_vector_type(8)));
typedef float f32x4 __attribute__((ext_vector_type(4)));
typedef unsigned u32x4 __attribute__((ext_vector_type(4)));
constexpr int BM = 256, BK = 64, HALF = 128, HTB = HALF * BK * 2  , STAGE_BYTES = 8 * HTB, NXCD = 8, WGM = 8;

__host__ __device__ __forceinline__ int lds_byte(int r, int c) { const int st = (r >> 4) * 2 + (c >> 5), rr = r & 15, cc = c & 31, ob = rr * 64 + cc * 2; return st * 1024 + (ob ^ (((ob >> 9) & 1) << 5)); }
__host__ __device__ __forceinline__ void stage_rc(int b, int& R, int& C) { const int st = b / 1024, sb = b % 1024, swz = sb ^ (((sb >> 9) & 1) << 5); R = (st >> 1) * 16 + swz / 64; C = (st & 1) * 32 + (swz % 64) / 2; }
__host__ __device__ __forceinline__ int perm32(int rho) { const int n = rho >> 4, i = rho & 15; return 8 * (i >> 2) + 4 * n + (i & 3); }

struct Unit { int pm, pn; };
struct Gemm { const bf16_t* A; const bf16_t* Bt; int M, N, K; };

struct StaticOrder {
    int nM, nN, nwg, G, c;
    __host__ __device__ void init(int M, int N, int G_, int c_) { nM = M / BM; nN = N / BM; nwg = nM * nN; G = G_; c = c_; }
    __host__ __device__ bool next(int i, Unit& u) const {
        const long L = (long)i * G + c; if (L >= nwg) return false;
        int wgid = (int)L; { const int q = nwg / NXCD, r = nwg % NXCD, xcd = wgid % NXCD, off = wgid / NXCD; wgid = (xcd < r ? xcd * (q + 1) : r * (q + 1) + (xcd - r) * q) + off; }
        const int nig = WGM * nN, gid = wgid / nig, fm = gid * WGM, gsz = (nM - fm) < WGM ? (nM - fm) : WGM;
        u.pm = fm + ((wgid % nig) % gsz); u.pn = (wgid % nig) / gsz; return true;
    }
    __device__ __forceinline__ void a_ready(const Unit&) const {}
    __device__ __forceinline__ void done(const Unit&) const {}
};
__device__ __forceinline__ unsigned cvt_pk_bf16(float lo, float hi) { unsigned r; asm volatile("v_cvt_pk_bf16_f32 %0, %1, %2" : "=v"(r) : "v"(lo), "v"(hi)); return r; }
}
namespace pg8 {
constexpr int TOK = 65536;
constexpr size_t TSTRIDE = (size_t)TOK * 1024;
constexpr float QK_C2 = 0.125f * 1.4426950408889634f;
typedef unsigned u32x2 __attribute__((ext_vector_type(2)));
typedef _Float16 h16x2 __attribute__((ext_vector_type(2)));
__device__ __forceinline__ unsigned pk_h2(float lo, float hi) { h16x2 v = {(_Float16)lo, (_Float16)hi}; return __builtin_bit_cast(unsigned, v); }
__device__ __forceinline__ float sigm(float x) { return __builtin_amdgcn_rcpf(1.0f + __expf(-x)); }
__device__ __forceinline__ float silu(float x) { return x * sigm(x); }
__device__ __forceinline__ float row_rstd(const float* ss, int row, float eps) { const float* q = ss + row; float t[4];
#pragma unroll
    for (int j = 0; j < 4; ++j) t[j] = (q[(size_t)j * TOK] + q[(size_t)(4 + j) * TOK]) + (q[(size_t)(8 + j) * TOK] + q[(size_t)(12 + j) * TOK]);
    return rsqrtf(((t[0] + t[1]) + (t[2] + t[3])) * (1.0f / 1024.0f) + eps); }

#define PG8_LOAD_RS(rs8, RS) do { const int sl_ = ((const PG8_LAS unsigned char*)(RS))[u.pm]; const PG8_LAS float* rt_ = (const PG8_LAS float*)((const PG8_LAS unsigned char*)(RS) + 256) + sl_ * 256; \
    _Pragma("unroll") for (int ai = 0; ai < 2; ++ai) _Pragma("unroll") for (int m = 0; m < 4; ++m) rs8[ai * 4 + m] = rt_[ai * HALF + wr * 64 + m * 16 + fr]; } while (0)
struct EpiQKV {
    static constexpr bool PERM = true, AFTER_DRAIN = false;
    bf16_t* P; const PG8_LAS unsigned char* ss; const float* cs;
    __device__ __forceinline__ void operator()(const f32x4 (&acc)[2][2][4][2], const Unit& u, int wr, int wc, int fr, int fq) const {
        const int colt = u.pn * BM, t = colt >> 10;
        bf16_t* base = P + (size_t)t * TSTRIDE;
        const int col0 = (colt & 1023) + wc * 32 + 8 * fq, i0 = (wc & 1) * 16 + 4 * fq;
        const float qs = (t == 0) ? QK_C2 : 1.0f;
        float rs8[8]; PG8_LOAD_RS(rs8, ss);
#pragma unroll
        for (int ai = 0; ai < 2; ++ai) {
            f32x4 c01a[4], c23a[4];
            if (t < 2) {
#pragma unroll
                for (int m = 0; m < 4; ++m) { const float* cp = cs + (size_t)(u.pm * BM + ai * HALF + wr * 64 + m * 16 + fr) * 64 + i0 * 2; c01a[m] = *(const f32x4*)cp; c23a[m] = *(const f32x4*)(cp + 4); }
            }
#pragma unroll
            for (int m = 0; m < 4; ++m) {
                const int row = u.pm * BM + ai * HALF + wr * 64 + m * 16 + fr;
                const float rs = rs8[ai * 4 + m];
                f32x4 c01 = {1.f, 0.f, 1.f, 0.f}, c23 = {1.f, 0.f, 1.f, 0.f};
                if (t < 2) { c01 = c01a[m]; c23 = c23a[m]; }
                bf16_t* rowp = base + (size_t)row * 1024 + col0;
#pragma unroll
                for (int bj = 0; bj < 2; ++bj) {
                    f32x4 v0 = acc[ai][bj][m][0] * rs, v1 = acc[ai][bj][m][1] * rs;
                    if (t < 2) {
                        f32x4 w0, w1;
                        w0[0] = v0[0] * c01[0] - v0[1] * c01[1]; w0[1] = v0[1] * c01[0] + v0[0] * c01[1];
                        w0[2] = v0[2] * c01[2] - v0[3] * c01[3]; w0[3] = v0[3] * c01[2] + v0[2] * c01[3];
                        w1[0] = v1[0] * c23[0] - v1[1] * c23[1]; w1[1] = v1[1] * c23[0] + v1[0] * c23[1];
                        w1[2] = v1[2] * c23[2] - v1[3] * c23[3]; w1[3] = v1[3] * c23[2] + v1[2] * c23[3];
                        v0 = w0 * qs; v1 = w1 * qs;
                    }
                    u32x4 w; w.x = cvt_pk_bf16(v0[0], v0[1]); w.y = cvt_pk_bf16(v0[2], v0[3]); w.z = cvt_pk_bf16(v1[0], v1[1]); w.w = cvt_pk_bf16(v1[2], v1[3]);
                    *(u32x4*)(rowp + bj * HALF) = w;
                }
            }
            asm volatile("" ::: "memory");
        }
    }
};
struct EpiHG {
    static constexpr bool PERM = true, AFTER_DRAIN = false;
    bf16_t* P; const PG8_LAS unsigned char* ss; const float* lb;
    __device__ __forceinline__ void operator()(const f32x4 (&acc)[2][2][4][2], const Unit& u, int wr, int wc, int fr, int fq) const {
        const int colt = u.pn * BM, t = colt >> 10;
        bf16_t* base = P + (size_t)t * TSTRIDE;
        const int col0 = (colt & 1023) + wc * 32 + 8 * fq;
        f32x4 lb0[2] = {{0.f, 0.f, 0.f, 0.f}, {0.f, 0.f, 0.f, 0.f}}, lb1[2] = {{0.f, 0.f, 0.f, 0.f}, {0.f, 0.f, 0.f, 0.f}};
        if (t == 1) {
#pragma unroll
            for (int bj = 0; bj < 2; ++bj) { lb0[bj] = *(const f32x4*)(lb + col0 + bj * HALF); lb1[bj] = *(const f32x4*)(lb + col0 + bj * HALF + 4); }
        }
        float rs8[8]; PG8_LOAD_RS(rs8, ss);
#pragma unroll
        for (int ai = 0; ai < 2; ++ai)
#pragma unroll
            for (int m = 0; m < 4; ++m) {
                const int row = u.pm * BM + ai * HALF + wr * 64 + m * 16 + fr;
                const float rs = rs8[ai * 4 + m];
                bf16_t* rowp = base + (size_t)row * 1024 + col0;
#pragma unroll
                for (int bj = 0; bj < 2; ++bj) {
                    f32x4 v0 = acc[ai][bj][m][0] * rs, v1 = acc[ai][bj][m][1] * rs;
                    u32x4 w;
                    if (t == 1) {
#pragma unroll
                        for (int j = 0; j < 4; ++j) {
                            v0[j] = __logf(lb0[bj][j] + (1.0f - lb0[bj][j]) * sigm(v0[j]));
                            v1[j] = __logf(lb1[bj][j] + (1.0f - lb1[bj][j]) * sigm(v1[j]));
                        }
                        w.x = pk_h2(v0[0], v0[1]); w.y = pk_h2(v0[2], v0[3]); w.z = pk_h2(v1[0], v1[1]); w.w = pk_h2(v1[2], v1[3]);
                    } else {
                        if (t != 2) {
#pragma unroll
                            for (int j = 0; j < 4; ++j) { v0[j] = silu(v0[j]); v1[j] = silu(v1[j]); }
                        }
                        w.x = cvt_pk_bf16(v0[0], v0[1]); w.y = cvt_pk_bf16(v0[2], v0[3]); w.z = cvt_pk_bf16(v1[0], v1[1]); w.w = cvt_pk_bf16(v1[2], v1[3]);
                    }
                    *(u32x4*)(rowp + bj * HALF) = w;
                }
            }
    }
};
struct EpiFFN {
    static constexpr bool PERM = true, AFTER_DRAIN = false;
    bf16_t* H; const PG8_LAS unsigned char* ss;
    __device__ __forceinline__ void operator()(const f32x4 (&acc)[2][2][4][2], const Unit& u, int wr, int wc, int fr, int fq) const {
        const int hcol0 = u.pn * HALF + wc * 32 + 8 * fq;
        float rs8[8]; PG8_LOAD_RS(rs8, ss);
#pragma unroll
        for (int ai = 0; ai < 2; ++ai)
#pragma unroll
            for (int m = 0; m < 4; ++m) {
                const int row = u.pm * BM + ai * HALF + wr * 64 + m * 16 + fr;
                const float rs = rs8[ai * 4 + m];
                const f32x4 g0 = acc[ai][0][m][0] * rs, g1 = acc[ai][0][m][1] * rs, u0 = acc[ai][1][m][0] * rs, u1 = acc[ai][1][m][1] * rs;
                u32x4 w; w.x = cvt_pk_bf16(silu(g0[0]) * u0[0], silu(g0[1]) * u0[1]); w.y = cvt_pk_bf16(silu(g0[2]) * u0[2], silu(g0[3]) * u0[3]);
                w.z = cvt_pk_bf16(silu(g1[0]) * u1[0], silu(g1[1]) * u1[1]); w.w = cvt_pk_bf16(silu(g1[2]) * u1[2], silu(g1[3]) * u1[3]);
                *(u32x4*)(H + (size_t)row * 2816 + hcol0) = w;
            }
    }
};
__device__ __forceinline__ float bfl(unsigned w) { return __builtin_bit_cast(float, w << 16); }
__device__ __forceinline__ float bfh(unsigned w) { return __builtin_bit_cast(float, w & 0xffff0000u); }
struct EpiRes {
    static constexpr bool PERM = true, AFTER_DRAIN = false;
    bf16_t* xn; float* ssn;
    __device__ __forceinline__ void operator()(const f32x4 (&acc)[2][2][4][2], const Unit& u, int wr, int wc, int fr, int fq) const {
        const int col0 = u.pn * BM + wc * 32 + 8 * fq;
        float s8[8];
#pragma unroll
        for (int ai = 0; ai < 2; ++ai) {
            u32x4 bres[4][2];
#pragma unroll
            for (int m = 0; m < 4; ++m)
#pragma unroll
                for (int bj = 0; bj < 2; ++bj) bres[m][bj] = *(const u32x4*)(xn + (size_t)(u.pm * BM + ai * HALF + wr * 64 + m * 16 + fr) * 1024 + col0 + bj * HALF);
#pragma unroll
            for (int m = 0; m < 4; ++m) {
                const int row = u.pm * BM + ai * HALF + wr * 64 + m * 16 + fr;
                bf16_t* rowp = xn + (size_t)row * 1024 + col0;
                float s = 0.f;
#pragma unroll
                for (int bj = 0; bj < 2; ++bj) {
                    const u32x4 b = bres[m][bj];
                    const f32x4 v0 = acc[ai][bj][m][0] + (f32x4){bfl(b.x), bfh(b.x), bfl(b.y), bfh(b.y)}, v1 = acc[ai][bj][m][1] + (f32x4){bfl(b.z), bfh(b.z), bfl(b.w), bfh(b.w)};
                    u32x4 w; w.x = cvt_pk_bf16(v0[0], v0[1]); w.y = cvt_pk_bf16(v0[2], v0[3]); w.z = cvt_pk_bf16(v1[0], v1[1]); w.w = cvt_pk_bf16(v1[2], v1[3]);
                    *(u32x4*)(rowp + bj * HALF) = w;
                    s += (bfl(w.x) * bfl(w.x) + bfh(w.x) * bfh(w.x)) + (bfl(w.y) * bfl(w.y) + bfh(w.y) * bfh(w.y));
                    s += (bfl(w.z) * bfl(w.z) + bfh(w.z) * bfh(w.z)) + (bfl(w.w) * bfl(w.w) + bfh(w.w) * bfh(w.w));
                }
                s += __shfl_xor(s, 16); s += __shfl_xor(s, 32);
                s8[ai * 4 + m] = s;
            }
        }
#pragma unroll
        for (int ai = 0; ai < 2; ++ai) { const float v = (fq == 0) ? s8[ai * 4] : (fq == 1) ? s8[ai * 4 + 1] : (fq == 2) ? s8[ai * 4 + 2] : s8[ai * 4 + 3];
            ssn[(size_t)(u.pn * 4 + wc) * TOK + u.pm * BM + ai * HALF + wr * 64 + fq * 16 + fr] = v; }
    }
};
}
namespace pg8 {
template <class Epi, class Sched, bool ALIGN_EPI = false, bool SP2 = false>
__device__ __forceinline__ void gemm_phase(PG8_LAS unsigned char* lds, const Gemm g, const Sched& S, const Epi& E) {
    const int tid = mk_tid(), wid = __builtin_amdgcn_readfirstlane(tid >> 6), lane = tid & 63, wr = wid >> 2, wc = wid & 3, fr = lane & 15, fq = lane >> 4;
    const int K = g.K, nt = K / BK;
    unsigned voffA[2], voffB[2];
#pragma unroll
    for (int i = 0; i < 2; ++i) { int R, C; stage_rc(tid * 16 + i * 8192, R, C); const int Rb = Epi::PERM ? ((R & ~31) + perm32(R & 31)) : R;
        voffA[i] = (unsigned)(R * K + C) * 2u; voffB[i] = (unsigned)(Rb * K + C) * 2u; }
    const size_t kstep = (size_t)(BK * 2);
    const size_t hstep = (size_t)HALF * K * 2;
    const size_t tstep = 2 * hstep;
    const unsigned ldsw = (unsigned)wid * 1024u;
    const int aoff = lds_byte(wr * 64 + fr, fq * 8), boff = lds_byte(wc * 32 + fr, fq * 8);
#define PG8_SA(b, h) (((b) * 2 + (h)) * HTB)
#define PG8_SB(b, h) ((4 + (b) * 2 + (h)) * HTB)
#define PG8_STAGE(bufoff, gbase, voff) do { _Pragma("unroll") for (int _i = 0; _i < 2; ++_i) \
        __builtin_amdgcn_global_load_lds((const unsigned*)((const char*)(gbase) + (voff)[_i]), (PG8_LAS unsigned*)(lds + (bufoff) + ldsw + _i * 8192), 16, 0, 0); } while (0)
#define PG8_LDA(dst, b, h) do { _Pragma("unroll") for (int m = 0; m < 4; ++m) _Pragma("unroll") for (int k = 0; k < 2; ++k) dst[m][k] = *(const PG8_LAS bf16x8*)(lds + PG8_SA(b, h) + aoff + m * 2048 + k * 1024); } while (0)
#define PG8_LDB(dst, b, h) do { _Pragma("unroll") for (int n = 0; n < 2; ++n) _Pragma("unroll") for (int k = 0; k < 2; ++k) dst[n][k] = *(const PG8_LAS bf16x8*)(lds + PG8_SB(b, h) + boff + n * 2048 + k * 1024); } while (0)
#define PG8_MMA(ai, bj, At, Bt) do { __builtin_amdgcn_s_setprio(1); _Pragma("unroll") for (int m = 0; m < 4; ++m) _Pragma("unroll") for (int n = 0; n < 2; ++n) _Pragma("unroll") for (int k = 0; k < 2; ++k) \
        acc[ai][bj][m][n] = __builtin_amdgcn_mfma_f32_16x16x32_bf16(Bt[n][k], At[m][k], acc[ai][bj][m][n], 0, 0, 0); __builtin_amdgcn_s_setprio(0); } while (0)
#define PG8_WAIT_V(n) asm volatile("s_waitcnt vmcnt(" #n ")" ::: "memory")
#define PG8_WAIT_L(n) asm volatile("s_waitcnt lgkmcnt(" #n ")" ::: "memory")
#define PG8_BAR __builtin_amdgcn_s_barrier()
#define PG8_SCHED __builtin_amdgcn_sched_barrier(0)
    Unit cur, nxt; int ui = 0;
    if (!S.next(0, cur)) return;
    f32x4 acc[2][2][4][2];
#pragma unroll
    for (int a = 0; a < 2; ++a)
#pragma unroll
        for (int b = 0; b < 2; ++b)
#pragma unroll
            for (int m = 0; m < 4; ++m)
#pragma unroll
                for (int n = 0; n < 2; ++n) acc[a][b][m][n] = (f32x4){0.f, 0.f, 0.f, 0.f};
    bf16x8 At[4][2], B0[2][2], B1[2][2];
    const char* cA = (const char*)g.A + (size_t)cur.pm * tstep; const char* cB = (const char*)g.Bt + (size_t)cur.pn * tstep;
    S.a_ready(cur);
    if constexpr (SP2) {
        PG8_STAGE(PG8_SB(0, 0), cB, voffB); PG8_STAGE(PG8_SB(0, 1), cB + hstep, voffB); PG8_STAGE(PG8_SA(0, 0), cA, voffA); PG8_STAGE(PG8_SA(0, 1), cA + hstep, voffA);
        if (wr == 1) PG8_BAR;
        PG8_WAIT_V(2); PG8_BAR;
        PG8_STAGE(PG8_SB(1, 0), cB + kstep, voffB); PG8_STAGE(PG8_SA(1, 0), cA + kstep, voffA); PG8_STAGE(PG8_SB(1, 1), cB + hstep + kstep, voffB);
        PG8_WAIT_V(6); PG8_BAR;
    } else {
        PG8_STAGE(PG8_SB(0, 0), cB, voffB); PG8_STAGE(PG8_SA(0, 0), cA, voffA); PG8_STAGE(PG8_SB(0, 1), cB + hstep, voffB); PG8_STAGE(PG8_SA(0, 1), cA + hstep, voffA);
        if (wr == 1) PG8_BAR;
        PG8_WAIT_V(4); PG8_BAR;
        PG8_STAGE(PG8_SB(1, 0), cB + kstep, voffB); PG8_STAGE(PG8_SA(1, 0), cA + kstep, voffA); PG8_STAGE(PG8_SB(1, 1), cB + hstep + kstep, voffB);
        PG8_WAIT_V(6); PG8_BAR;
    }
    for (;;) {
        const bool has_next = S.next(ui + 1, nxt);
        const char* nA = has_next ? (const char*)g.A + (size_t)nxt.pm * tstep : cA; const char* nB = has_next ? (const char*)g.Bt + (size_t)nxt.pn * tstep : cB;
        for (int t = 0; t < nt; t += 2) {
            const bool last = (t == nt - 2);
            const char* a1 = cA + (size_t)(t + 1) * kstep;
            const char* a2 = last ? nA : cA + (size_t)(t + 2) * kstep; const char* b2 = last ? nB : cB + (size_t)(t + 2) * kstep;
            const char* a3 = a2 + kstep; const char* b3 = b2 + kstep;
            if (last && has_next) S.a_ready(nxt);
            if constexpr (SP2) {
            PG8_LDB(B0, 0, 0); PG8_LDB(B1, 0, 1); PG8_SCHED; PG8_LDA(At, 0, 0); PG8_STAGE(PG8_SA(1, 1), a1 + hstep, voffA);
            PG8_WAIT_V(8); PG8_WAIT_L(0); PG8_BAR; PG8_MMA(0, 0, At, B0); PG8_MMA(0, 1, At, B1); PG8_BAR; PG8_SCHED;
            PG8_LDA(At, 0, 1); PG8_STAGE(PG8_SB(0, 0), b2, voffB); PG8_STAGE(PG8_SB(0, 1), b2 + hstep, voffB); PG8_STAGE(PG8_SA(0, 0), a2, voffA);
            PG8_WAIT_V(8); PG8_WAIT_L(0); PG8_BAR; PG8_MMA(1, 0, At, B0); PG8_MMA(1, 1, At, B1); PG8_BAR; PG8_SCHED;
            PG8_LDB(B0, 1, 0); PG8_LDB(B1, 1, 1); PG8_SCHED; PG8_LDA(At, 1, 0); PG8_STAGE(PG8_SA(0, 1), a2 + hstep, voffA);
            PG8_WAIT_V(8); PG8_WAIT_L(0); PG8_BAR; PG8_MMA(0, 0, At, B0); PG8_MMA(0, 1, At, B1); PG8_BAR; PG8_SCHED;
            PG8_LDA(At, 1, 1); PG8_STAGE(PG8_SB(1, 0), b3, voffB); PG8_STAGE(PG8_SB(1, 1), b3 + hstep, voffB); PG8_STAGE(PG8_SA(1, 0), a3, voffA);
            PG8_WAIT_V(8); PG8_WAIT_L(0); PG8_BAR; PG8_MMA(1, 0, At, B0); PG8_MMA(1, 1, At, B1); PG8_BAR; PG8_SCHED;
            } else {
            PG8_LDB(B0, 0, 0); PG8_SCHED; PG8_LDA(At, 0, 0); PG8_STAGE(PG8_SA(1, 1), a1 + hstep, voffA);
            PG8_WAIT_L(8); PG8_BAR; PG8_WAIT_L(0); PG8_MMA(0, 0, At, B0); PG8_BAR; PG8_SCHED;
            PG8_LDB(B1, 0, 1); PG8_STAGE(PG8_SB(0, 0), b2, voffB);
            PG8_BAR; PG8_WAIT_L(0); PG8_MMA(0, 1, At, B1); PG8_BAR;
            PG8_LDA(At, 0, 1); PG8_STAGE(PG8_SA(0, 0), a2, voffA);
            PG8_BAR; PG8_WAIT_L(0); PG8_MMA(1, 0, At, B0); PG8_BAR; PG8_SCHED;
            PG8_STAGE(PG8_SB(0, 1), b2 + hstep, voffB);
            PG8_WAIT_V(6); PG8_BAR; PG8_MMA(1, 1, At, B1); PG8_BAR;
            PG8_LDB(B0, 1, 0); PG8_SCHED; PG8_LDA(At, 1, 0); PG8_STAGE(PG8_SA(0, 1), a2 + hstep, voffA);
            PG8_WAIT_L(8); PG8_BAR; PG8_WAIT_L(0); PG8_MMA(0, 0, At, B0); PG8_BAR; PG8_SCHED;
            PG8_LDB(B1, 1, 1); PG8_STAGE(PG8_SB(1, 0), b3, voffB);
            PG8_BAR; PG8_WAIT_L(0); PG8_MMA(0, 1, At, B1); PG8_BAR;
            PG8_LDA(At, 1, 1); PG8_STAGE(PG8_SA(1, 0), a3, voffA);
            PG8_BAR; PG8_WAIT_L(0); PG8_MMA(1, 0, At, B0); PG8_BAR; PG8_SCHED;
            PG8_STAGE(PG8_SB(1, 1), b3 + hstep, voffB);
            PG8_WAIT_V(6); PG8_BAR; PG8_MMA(1, 1, At, B1); PG8_BAR;
            }
        }
        if constexpr (ALIGN_EPI) { if (wr == 0) PG8_BAR; }
        if constexpr (!Epi::AFTER_DRAIN) { E(acc, cur, wr, wc, fr, fq); S.done(cur); }
        if (!has_next) break;
#pragma unroll
        for (int a = 0; a < 2; ++a)
#pragma unroll
            for (int b = 0; b < 2; ++b)
#pragma unroll
                for (int m = 0; m < 4; ++m)
#pragma unroll
                    for (int n = 0; n < 2; ++n) acc[a][b][m][n] = (f32x4){0.f, 0.f, 0.f, 0.f};
        cur = nxt; cA = nA; cB = nB; ++ui;
        if constexpr (ALIGN_EPI) { if (wr == 1) PG8_BAR; }
    }
    PG8_WAIT_V(0);
    if constexpr (!ALIGN_EPI) { if (wr == 0) PG8_BAR; }
    PG8_BAR;
    if constexpr (Epi::AFTER_DRAIN) { E.fused(acc, cur, wr, wc, fr, fq, lds, wid, lane); S.done(cur); }
#undef PG8_SA
#undef PG8_SB
#undef PG8_STAGE
#undef PG8_LDA
#undef PG8_LDB
#undef PG8_MMA
#undef PG8_WAIT_V
#undef PG8_WAIT_L
#undef PG8_BAR
#undef PG8_SCHED
}
}
namespace attn_body {
using bf16=__hip_bfloat16;
using bf16x8=__attribute__((ext_vector_type(8)))short;
using s16x4=__attribute__((ext_vector_type(4)))short;
using f32x16=__attribute__((ext_vector_type(16)))float;
using u32x4=__attribute__((ext_vector_type(4)))unsigned;
constexpr int SEQ=4096,D=64,DM=1024;
constexpr int NW=8,QBLK=32,QB=QBLK*NW,KVBLK=64,NQB=SEQ/QB;
constexpr int ATTN_PITCH=DM, ATTN_UNIT_ROWS=QB;
__device__ __forceinline__ int crow(int r,int hi){return (r&3)+8*(r>>2)+4*hi;}
#define SBAR() __builtin_amdgcn_sched_barrier(0)
__device__ __forceinline__ void cmask(f32x16&p0,f32x16&p1,int jb,int qrel,int hi){
  const float NEG=-INFINITY; int kb=64*jb+4*hi;
  #pragma unroll
  for(int r=0;r<16;++r){int kv=kb+(r&3)+8*(r>>2); if(kv>qrel)p0[r]=NEG; if(kv+32>qrel)p1[r]=NEG;}
}

constexpr int NSLOT=3, SLOTB=8192;
constexpr int LDS_K=0, LDS_V=NSLOT*SLOTB, LDS_WS=2*NSLOT*SLOTB, LDS_OST=LDS_WS+NW*64*4, LDS_BYTES=LDS_OST+NW*4096;
constexpr float C2=0.125f*1.4426950408889634f;
__device__ __forceinline__ void glds16(const void*gsrc,unsigned lds_dst){unsigned keep;
  asm volatile("s_mov_b32 %0, m0\n\ts_mov_b32 m0, %2\n\ts_nop 0\n\tglobal_load_lds_dwordx4 %1, off\n\ts_mov_b32 m0, %0":"=&s"(keep):"v"(gsrc),"s"(lds_dst):"memory");}
__device__ __forceinline__ float max3f(float a,float b,float c){float r;asm("v_max3_f32 %0, %1, %2, %3":"=v"(r):"v"(a),"v"(b),"v"(c));return r;}
__device__ __forceinline__ float max2f(float a,float b){float r;asm("v_max_f32_e32 %0, %1, %2":"=v"(r):"v"(a),"v"(b));return r;}
__device__ __forceinline__ float fadd_s(float a,float b){float r;asm("v_add_f32_e32 %0, %1, %2":"=v"(r):"v"(a),"v"(b));return r;}
__device__ __forceinline__ float fsub_s(float a,float b){float r;asm("v_sub_f32_e32 %0, %1, %2":"=v"(r):"v"(a),"v"(b));return r;}
typedef float f32x2_t __attribute__((ext_vector_type(2))); typedef __bf16 bf16x2_t __attribute__((ext_vector_type(2)));
__device__ __forceinline__ unsigned cvtpk_s(float lo,float hi){f32x2_t v={lo,hi};bf16x2_t b=__builtin_convertvector(v,bf16x2_t);return __builtin_bit_cast(unsigned,b);}
#define WAIT_BAR(N) asm volatile("s_waitcnt vmcnt(" #N ") lgkmcnt(0)\n\ts_barrier":::"memory")

__device__ __forceinline__ void qkt(f32x16&p0,f32x16&p1,const char*Kslot,const bf16x8*qr,const f32x16&negm,int r32,int hi){
  const char*kb=Kslot+hi*1024+r32*16;
  #pragma unroll
  for(int d0=0;d0<4;++d0){
    const bf16x8 b0=*reinterpret_cast<const bf16x8*>(kb+d0*2048);
    const bf16x8 b1=*reinterpret_cast<const bf16x8*>(kb+d0*2048+512);
    if(d0==0){p0=__builtin_amdgcn_mfma_f32_32x32x16_bf16(b0,qr[0],negm,0,0,0);p1=__builtin_amdgcn_mfma_f32_32x32x16_bf16(b1,qr[0],negm,0,0,0);}
    else{p0=__builtin_amdgcn_mfma_f32_32x32x16_bf16(b0,qr[d0],p0,0,0,0);p1=__builtin_amdgcn_mfma_f32_32x32x16_bf16(b1,qr[d0],p1,0,0,0);}}
}
typedef __attribute__((address_space(3))) const char* lds_cptr;
typedef short v4i16_t __attribute__((ext_vector_type(4)));
__device__ __forceinline__ void kload8(bf16x8*kf,lds_cptr kp){
  kf[0]=*(const __attribute__((address_space(3))) bf16x8*)(kp);      kf[1]=*(const __attribute__((address_space(3))) bf16x8*)(kp+512);
  kf[2]=*(const __attribute__((address_space(3))) bf16x8*)(kp+2048); kf[3]=*(const __attribute__((address_space(3))) bf16x8*)(kp+2560);
  kf[4]=*(const __attribute__((address_space(3))) bf16x8*)(kp+4096); kf[5]=*(const __attribute__((address_space(3))) bf16x8*)(kp+4608);
  kf[6]=*(const __attribute__((address_space(3))) bf16x8*)(kp+6144); kf[7]=*(const __attribute__((address_space(3))) bf16x8*)(kp+6656);
}
__device__ __forceinline__ void kload2(bf16x8*kf,lds_cptr kp,int j){ kf[2*j]=*(const __attribute__((address_space(3))) bf16x8*)(kp+j*2048); kf[2*j+1]=*(const __attribute__((address_space(3))) bf16x8*)(kp+j*2048+512); }
__device__ __forceinline__ s16x4 vtr(lds_cptr p){ return __builtin_bit_cast(s16x4,__builtin_amdgcn_ds_read_tr16_b64_v4i16((__attribute__((address_space(3))) v4i16_t*)p)); }
__device__ __forceinline__ float rowmax(const f32x16&p0,const f32x16&p1){
  float a=max3f(p0[0],p0[1],p1[0]),b=max3f(p0[2],p0[3],p1[1]);a=max3f(a,p1[2],p1[3]);
  #pragma unroll
  for(int r=4;r<16;r+=4){a=max3f(a,p0[r],p0[r+1]);b=max3f(b,p0[r+2],p0[r+3]);a=max3f(a,p1[r],p1[r+1]);b=max3f(b,p1[r+2],p1[r+3]);}
  const float m=max2f(a,b);
  auto rr=__builtin_amdgcn_permlane32_swap(__float_as_uint(m),__float_as_uint(m),false,false);
  return max2f(__uint_as_float(rr[0]),__uint_as_float(rr[1]));
}
__device__ __forceinline__ void pv(f32x16*o,int vb,bf16x8 pa0,bf16x8 pa1,bf16x8 pa2,bf16x8 pa3){
  #pragma unroll
  for(int d0=0;d0<2;++d0){s16x4 lo[4],hi[4];
    #pragma unroll
    for(int ks=0;ks<4;++ks){
      asm volatile("ds_read_b64_tr_b16 %0,%1 offset:%c2":"=&v"(lo[ks]):"v"(vb),"i"(d0*4096+ks*1024):"memory");
      asm volatile("ds_read_b64_tr_b16 %0,%1 offset:%c2":"=&v"(hi[ks]):"v"(vb),"i"(d0*4096+ks*1024+512):"memory");}
    asm volatile("s_waitcnt lgkmcnt(0)":::"memory");SBAR();
    #define PK(k) (bf16x8){lo[k][0],lo[k][1],lo[k][2],lo[k][3],hi[k][0],hi[k][1],hi[k][2],hi[k][3]}
    o[d0]=__builtin_amdgcn_mfma_f32_32x32x16_bf16(pa0,PK(0),o[d0],0,0,0);
    o[d0]=__builtin_amdgcn_mfma_f32_32x32x16_bf16(pa1,PK(1),o[d0],0,0,0);
    o[d0]=__builtin_amdgcn_mfma_f32_32x32x16_bf16(pa2,PK(2),o[d0],0,0,0);
    o[d0]=__builtin_amdgcn_mfma_f32_32x32x16_bf16(pa3,PK(3),o[d0],0,0,0);
    #undef PK
  }
}

#ifndef ATTN_STORE16
#define ATTN_STORE16(p,v) (*(u32x4*)(p)=(v))
#endif
template<int THRL> __device__ __forceinline__ void attn_unit(int b,int qcol,int vcol,int qb,const bf16*Q,const bf16*__restrict__ K,const bf16*__restrict__ V,bf16*O,char*shm){
  const int tid=mk_tid(),lane=tid&63,r32=lane&31,hi=lane>>5; const int wid=__builtin_amdgcn_readfirstlane(tid>>6);
  const long rowbase=(long)b*SEQ; const int q0=qb*QB;
  const bf16*Qw=Q+(rowbase+q0+wid*QBLK)*DM+qcol;
  const bf16*Kh=K+rowbase*DM+qcol,*Vh=V+rowbase*DM+vcol;
  const unsigned lds0=(unsigned)(uintptr_t)shm;
  float*wsf=(float*)(shm+LDS_WS)+wid*64;
  const bf16*ksrc=Kh+(long)lane*DM+wid*8;
  const bf16*vsrc=Vh+(long)(16*(wid&3)+(lane>>2))*DM+(wid>>2)*32+(lane&3)*8;
  const unsigned kdst=lds0+LDS_K+wid*1024, vdst=lds0+LDS_V+wid*1024;
  #define DMA_K(t,slot) glds16(ksrc+(long)(t)*KVBLK*DM,(unsigned)__builtin_amdgcn_readfirstlane(kdst+(slot)))
  #define DMA_V(t,slot) glds16(vsrc+(long)(t)*KVBLK*DM,(unsigned)__builtin_amdgcn_readfirstlane(vdst+(slot)))
  const int vb0=(int)(lds0+LDS_V)+((lane>>4)&1)*32+(lane&3)*8+(4*hi+((lane&15)>>2))*64;
  const char*Kbase=shm+LDS_K; bf16x8 kf[8];
  const lds_cptr shm3=(lds_cptr)shm; const lds_cptr kp0=shm3+LDS_K+hi*1024+r32*16; const lds_cptr vp0=shm3+LDS_V+((lane>>4)&1)*32+(lane&3)*8+(4*hi+((lane&15)>>2))*64;
  const int NT=(q0+QB)/KVBLK;
  DMA_K(0,0);DMA_V(0,0);DMA_K(1,SLOTB);
  bf16x8 qr[4];
  #pragma unroll
  for(int d0=0;d0<4;++d0)qr[d0]=*reinterpret_cast<const bf16x8*>(&Qw[(long)r32*DM+d0*16+hi*8]);
  float mhat=0.f,l_reg=0.f;f32x16 o[2];o[0]=f32x16{};o[1]=f32x16{};f32x16 negm=f32x16{};asm volatile("":"+v"(negm));
  const int qrel=wid*QBLK+r32;
  #define CMASK(P0,P1,t) do{int jb_=(t)-(NT-4); if(jb_>=0)cmask(P0,P1,jb_,qrel,hi);}while(0)
  bool resc=false;
  #define START(P0,P1) do{ const float rm=rowmax(P0,P1); resc=false; \
    { const float dl=rm; mhat=fadd_s(mhat,dl); \
      _Pragma("unroll") for(int r=0;r<16;++r){P0[r]=fsub_s(P0[r],dl);P1[r]=fsub_s(P1[r],dl);} \
      _Pragma("unroll") for(int r=0;r<16;++r)negm[r]=-mhat; asm volatile("":"+v"(negm)); } \
    _Pragma("unroll") for(int r=0;r<16;++r)P0[r]=__builtin_amdgcn_exp2f(P0[r]); }while(0)
  #define RESC() do{ if(resc){ asm volatile("s_waitcnt lgkmcnt(0)":::"memory"); \
      _Pragma("unroll") for(int d_=0;d_<2;++d_) _Pragma("unroll") for(int r=0;r<16;++r)o[d_][r]*=wsf[crow(r,hi)]; } }while(0)
  f32x16 pA0,pA1,pB0,pB1;
  int sl_prev=0,sl_cur=0,sl_next=SLOTB;
  #define ROT() do{sl_prev=sl_cur;sl_cur=sl_next;sl_next=(sl_next==(NSLOT-1)*SLOTB)?0:sl_next+SLOTB;}while(0)
  DMA_K(2,2*SLOTB);
  WAIT_BAR(3);
  qkt(pA0,pA1,Kbase,qr,negm,r32,hi);asm volatile("s_nop 15\n\ts_nop 7":"+v"(pA0),"+v"(pA1));CMASK(pA0,pA1,0);
  START(pA0,pA1);
  _Pragma("unroll") for(int r=0;r<16;++r)pA1[r]=__builtin_amdgcn_exp2f(pA1[r]);
  WAIT_BAR(0);
  DMA_K(3,0);DMA_V(1,SLOTB);
  ROT();
  kload8(kf,kp0+sl_cur);
  WAIT_BAR(2);
  s16x4 vlo[8],vhi[8]; u32x4 pw0,pw1,pw2,pw3;
  #define PKW(P,B) cvtpk_s(P[B],P[B+1])
  #define PAF(k) __builtin_bit_cast(bf16x8,pw##k)
  #define VFR(i) (bf16x8){vlo[i][0],vlo[i][1],vlo[i][2],vlo[i][3],vhi[i][0],vhi[i][1],vhi[i][2],vhi[i][3]}
  #define PIN(x) asm volatile("":"+v"(x))
  #define MX3(a,b,c) __builtin_fmaxf(__builtin_fmaxf((a),(b)),(c))
  #define GAPA(MF,A0,A1,A2,A3,W0,W1,PW) do{ MF; sacc+=A0; sacc+=A1; sacc+=A2; sacc+=A3; PIN(sacc); W0; W1; PIN(PW); SBAR(); }while(0)
  #define EX(v) __builtin_amdgcn_exp2f(v)
  #define GAPB(MF,X,B) do{ MF; X[B]=EX(X[B]); X[B+1]=EX(X[B+1]); X[B+2]=EX(X[B+2]); X[B+3]=EX(X[B+3]); PIN(X); SBAR(); }while(0)
  #define VRD(i) do{ vlo[i]=vtr(vp_+(((i)>>2)*4096+((i)&3)*1024)); vhi[i]=vtr(vp_+(((i)>>2)*4096+((i)&3)*1024+512)); }while(0)
  #define KRD(G,j) do{ if(G){ kload2(kf,kp0+sl_next,j); SBAR(); } }while(0)
  #define STEP(C0,C1,P0,P1,t,GK,GV,GL) do{ SBAR(); \
    const lds_cptr vp_=vp0+sl_prev; \
    VRD(0); SBAR(); float sacc=(P0[0]+P0[1]); \
    GAPA(C0=__builtin_amdgcn_mfma_f32_32x32x16_bf16(kf[0],qr[0],negm,0,0,0), P0[2],P0[3],P0[4],P0[5],     pw0[0]=PKW(P0,0), pw0[1]=PKW(P0,2), pw0); \
    VRD(4); SBAR(); GAPA(C1=__builtin_amdgcn_mfma_f32_32x32x16_bf16(kf[1],qr[0],negm,0,0,0), P0[6],P0[7],P0[8],P0[9],     pw0[2]=PKW(P0,4), pw0[3]=PKW(P0,6), pw0); \
    VRD(1); SBAR(); GAPA(C0=__builtin_amdgcn_mfma_f32_32x32x16_bf16(kf[2],qr[1],C0,0,0,0),   P0[10],P0[11],P0[12],P0[13], pw1[0]=PKW(P0,8), pw1[1]=PKW(P0,10), pw1); \
    VRD(5); SBAR(); GAPA(C1=__builtin_amdgcn_mfma_f32_32x32x16_bf16(kf[3],qr[1],C1,0,0,0),   P0[14],P0[15],P1[0],P1[1],   pw1[2]=PKW(P0,12),pw1[3]=PKW(P0,14), pw1); \
    VRD(2); SBAR(); GAPA(C0=__builtin_amdgcn_mfma_f32_32x32x16_bf16(kf[4],qr[2],C0,0,0,0),   P1[2],P1[3],P1[4],P1[5],     pw2[0]=PKW(P1,0), pw2[1]=PKW(P1,2), pw2); \
    VRD(6); SBAR(); GAPA(C1=__builtin_amdgcn_mfma_f32_32x32x16_bf16(kf[5],qr[2],C1,0,0,0),   P1[6],P1[7],P1[8],P1[9],     pw2[2]=PKW(P1,4), pw2[3]=PKW(P1,6), pw2); \
    VRD(3); SBAR(); GAPA(C0=__builtin_amdgcn_mfma_f32_32x32x16_bf16(kf[6],qr[3],C0,0,0,0),   P1[10],P1[11],P1[12],P1[13], pw3[0]=PKW(P1,8), pw3[1]=PKW(P1,10), pw3); \
    VRD(7); SBAR(); GAPA(C1=__builtin_amdgcn_mfma_f32_32x32x16_bf16(kf[7],qr[3],C1,0,0,0),   P1[14],P1[15],0.f,0.f,       pw3[2]=PKW(P1,12),pw3[3]=PKW(P1,14), pw3); \
    l_reg+=sacc; \
    if(GK){DMA_K((t)+3,sl_cur);} if(GV){DMA_V((t)+1,sl_next);} \
    CMASK(C0,C1,t); \
    { float a=MX3(C0[0],C0[1],C1[0]),b=MX3(C0[2],C0[3],C1[1]); a=MX3(a,C1[2],C1[3]); \
      _Pragma("unroll") for(int r=4;r<16;r+=4){a=MX3(a,C0[r],C0[r+1]);b=MX3(b,C0[r+2],C0[r+3]);a=MX3(a,C1[r],C1[r+1]);b=MX3(b,C1[r+2],C1[r+3]);} \
      float rm=__builtin_fmaxf(a,b); { auto rr=__builtin_amdgcn_permlane32_swap(__float_as_uint(rm),__float_as_uint(rm),false,false); rm=__builtin_fmaxf(__uint_as_float(rr[0]),__uint_as_float(rr[1])); } \
      resc=false; \
      if(__builtin_expect(__any(rm>(float)THRL),0)){ const float dl=__builtin_fmaxf(rm,0.f); mhat+=dl; \
        _Pragma("unroll") for(int r=0;r<16;++r){C0[r]-=dl;C1[r]-=dl;} \
        _Pragma("unroll") for(int r=0;r<16;++r)negm[r]=-mhat; asm volatile("":"+v"(negm)); \
        const float f=__builtin_amdgcn_exp2f(-dl); l_reg*=f; if(hi==0)wsf[r32]=f; resc=true; } } \
    SBAR(); \
    GAPB(o[0]=__builtin_amdgcn_mfma_f32_32x32x16_bf16(PAF(0),VFR(0),o[0],0,0,0), C0,0); \
    GAPB(o[1]=__builtin_amdgcn_mfma_f32_32x32x16_bf16(PAF(0),VFR(4),o[1],0,0,0), C0,4); \
    KRD(GL,0); GAPB(o[0]=__builtin_amdgcn_mfma_f32_32x32x16_bf16(PAF(1),VFR(1),o[0],0,0,0), C0,8); \
    KRD(GL,1); GAPB(o[1]=__builtin_amdgcn_mfma_f32_32x32x16_bf16(PAF(1),VFR(5),o[1],0,0,0), C0,12); \
    KRD(GL,2); GAPB(o[0]=__builtin_amdgcn_mfma_f32_32x32x16_bf16(PAF(2),VFR(2),o[0],0,0,0), C1,0); \
    KRD(GL,3); GAPB(o[1]=__builtin_amdgcn_mfma_f32_32x32x16_bf16(PAF(2),VFR(6),o[1],0,0,0), C1,4); \
    GAPB(o[0]=__builtin_amdgcn_mfma_f32_32x32x16_bf16(PAF(3),VFR(3),o[0],0,0,0), C1,8); \
    GAPB(o[1]=__builtin_amdgcn_mfma_f32_32x32x16_bf16(PAF(3),VFR(7),o[1],0,0,0), C1,12); \
    }while(0)
  int t=1;
  #undef CMASK
  #define CMASK(P0,P1,t) do{}while(0)
  for(;t+5<NT;t+=2){
    STEP(pB0,pB1,pA0,pA1,t,true,true,true);     WAIT_BAR(2); RESC(); ROT();
    STEP(pA0,pA1,pB0,pB1,t+1,true,true,true);   WAIT_BAR(2); RESC(); ROT();
  }
  #undef CMASK
  #define CMASK(P0,P1,t) do{int jb_=(t)-(NT-4); if(jb_>=0)cmask(P0,P1,jb_,qrel,hi);}while(0)
  #define ENDW(tt) do{ if((tt)+3<NT){WAIT_BAR(2);} else if((tt)+2<NT){WAIT_BAR(1);} else {WAIT_BAR(0);} }while(0)
  for(;t+1<NT;t+=2){
    STEP(pB0,pB1,pA0,pA1,t,(t+3<NT),(t+1<NT),(t+1<NT));       ENDW(t);   RESC(); ROT();
    STEP(pA0,pA1,pB0,pB1,t+1,(t+4<NT),(t+2<NT),(t+2<NT));     ENDW(t+1); RESC(); ROT();
  }
  STEP(pB0,pB1,pA0,pA1,NT-1,false,false,false); RESC();
  { float sacc=pB0[0]+pB0[1]; _Pragma("unroll") for(int r=2;r<16;++r)sacc+=pB0[r]; _Pragma("unroll") for(int r=0;r<16;++r)sacc+=pB1[r]; l_reg+=sacc;
    pw0=(u32x4){PKW(pB0,0),PKW(pB0,2),PKW(pB0,4),PKW(pB0,6)};pw1=(u32x4){PKW(pB0,8),PKW(pB0,10),PKW(pB0,12),PKW(pB0,14)};pw2=(u32x4){PKW(pB1,0),PKW(pB1,2),PKW(pB1,4),PKW(pB1,6)};pw3=(u32x4){PKW(pB1,8),PKW(pB1,10),PKW(pB1,12),PKW(pB1,14)};
    SBAR(); pv(o,vb0+sl_cur,PAF(0),PAF(1),PAF(2),PAF(3)); }
  #undef PKW
  #undef PAF
  #undef VFR
  #undef PIN
  #undef MX3
  #undef GAPA
  #undef GAPB
  #undef EX
  #undef VRD
  #undef KRD
  #undef STEP
  #undef ENDW
  {auto rr=__builtin_amdgcn_permlane32_swap(__float_as_uint(l_reg),__float_as_uint(l_reg),false,false);l_reg=__uint_as_float(rr[0])+__uint_as_float(rr[1]);}
  if(hi==0)wsf[32+r32]=l_reg;asm volatile("s_waitcnt lgkmcnt(0)":::"memory");
  float rli[16];
  #pragma unroll
  for(int r=0;r<16;++r)rli[r]=__builtin_amdgcn_rcpf(wsf[32+crow(r,hi)]);
  bf16*Ow=O+(rowbase+q0+wid*QBLK)*DM+vcol;
  { _Float16*stg=(_Float16*)(shm+LDS_OST)+wid*2048;
    #pragma unroll
    for(int r=0;r<16;++r){const int orow=crow(r,hi);
      #pragma unroll
      for(int d0=0;d0<2;++d0)stg[orow*64+d0*32+r32]=(_Float16)(o[d0][r]*rli[r]);}
    asm volatile("s_waitcnt lgkmcnt(0)":::"memory");
    #pragma unroll
    for(int i=0;i<4;++i){const int row=i*8+(lane>>3),ch=lane&7; const u32x4 v=*(const u32x4*)(stg+row*64+ch*8); ATTN_STORE16(Ow+(long)row*DM+ch*8,v);} }
  asm volatile("s_waitcnt lgkmcnt(0)\n\ts_barrier":::"memory");
  #undef DMA_K
  #undef DMA_V
  #undef CMASK
  #undef START
  #undef RESC
  #undef ROT
}

__device__ __forceinline__ void pv4(f32x16*o,lds_cptr vp,bf16x8 pa0,bf16x8 pa1,bf16x8 pa2,bf16x8 pa3){
  #pragma unroll
  for(int d0=0;d0<4;++d0){
    s16x4 lo[4],hi[4];
    #pragma unroll
    for(int ks=0;ks<4;++ks){ lo[ks]=vtr(vp+(d0*4096+ks*1024)); hi[ks]=vtr(vp+(d0*4096+ks*1024+512)); }
    #define PKF(k) (bf16x8){lo[k][0],lo[k][1],lo[k][2],lo[k][3],hi[k][0],hi[k][1],hi[k][2],hi[k][3]}
    o[d0]=__builtin_amdgcn_mfma_f32_32x32x16_bf16(pa0,PKF(0),o[d0],0,0,0);
    o[d0]=__builtin_amdgcn_mfma_f32_32x32x16_bf16(pa1,PKF(1),o[d0],0,0,0);
    o[d0]=__builtin_amdgcn_mfma_f32_32x32x16_bf16(pa2,PKF(2),o[d0],0,0,0);
    o[d0]=__builtin_amdgcn_mfma_f32_32x32x16_bf16(pa3,PKF(3),o[d0],0,0,0);
    #undef PKF
  }
}
__device__ __forceinline__ float rowmax_c(const f32x16&p0,const f32x16&p1){
  float a=__builtin_fmaxf(__builtin_fmaxf(p0[0],p0[1]),p1[0]),b=__builtin_fmaxf(__builtin_fmaxf(p0[2],p0[3]),p1[1]); a=__builtin_fmaxf(__builtin_fmaxf(a,p1[2]),p1[3]);
  #pragma unroll
  for(int r=4;r<16;r+=4){a=__builtin_fmaxf(__builtin_fmaxf(a,p0[r]),p0[r+1]);b=__builtin_fmaxf(__builtin_fmaxf(b,p0[r+2]),p0[r+3]);a=__builtin_fmaxf(__builtin_fmaxf(a,p1[r]),p1[r+1]);b=__builtin_fmaxf(__builtin_fmaxf(b,p1[r+2]),p1[r+3]);}
  float rm=__builtin_fmaxf(a,b);
  auto rr=__builtin_amdgcn_permlane32_swap(__float_as_uint(rm),__float_as_uint(rm),false,false);
  return __builtin_fmaxf(__uint_as_float(rr[0]),__uint_as_float(rr[1]));
}
constexpr int A128_KS=8192, A128_VS=16384, A128_NS=3, A128_NV=4;
constexpr int A128_K=0, A128_V=A128_NS*A128_KS, A128_WS=A128_V+A128_NV*A128_VS, A128_OST=A128_WS+NW*64*4, A128_BYTES=A128_OST+NW*4096;
template<int THRL> __device__ __forceinline__ void attn128_unit(int b,int qcol,int vcol,int qb,const bf16*Q,const bf16*__restrict__ K,const bf16*__restrict__ V,bf16*O,char*shm){
  const int tid=mk_tid(),lane=tid&63,r32=lane&31,hi=lane>>5; const int wid=__builtin_amdgcn_readfirstlane(tid>>6);
  const long rowbase=(long)b*SEQ; const int q0=qb*QB;
  const bf16*Qw=Q+(rowbase+q0+wid*QBLK)*DM+qcol;
  const bf16*Kh=K+rowbase*DM+qcol,*Vh=V+rowbase*DM+vcol;
  const unsigned lds0=(unsigned)(uintptr_t)shm;
  float*wsf=(float*)(shm+A128_WS)+wid*64;
  const bf16*ksrc=Kh+(long)lane*DM+wid*8;
  const bf16*vsrc=Vh+(long)(16*(wid&3)+(lane>>2))*DM+(wid>>2)*32+(lane&3)*8;
  const unsigned kdst=lds0+A128_K+wid*1024, vdst=lds0+A128_V+wid*1024;
  #define DMA_T(t,sl,sv) do{ glds16(ksrc+(long)(t)*KVBLK*DM,(unsigned)__builtin_amdgcn_readfirstlane(kdst+(sl)*A128_KS)); \
      glds16(vsrc+(long)(t)*KVBLK*DM,(unsigned)__builtin_amdgcn_readfirstlane(vdst+(sv)*A128_VS)); \
      glds16(vsrc+(long)(t)*KVBLK*DM+64,(unsigned)__builtin_amdgcn_readfirstlane(vdst+(sv)*A128_VS+8192)); }while(0)
  const lds_cptr vb0=(lds_cptr)shm+A128_V+((lane>>4)&1)*32+(lane&3)*8+(4*hi+((lane&15)>>2))*64;
  const int NT=(q0+QB)/KVBLK;
  bf16x8 qr[4];
  #pragma unroll
  for(int d0=0;d0<4;++d0)qr[d0]=*reinterpret_cast<const bf16x8*>(&Qw[(long)r32*DM+d0*16+hi*8]);
  DMA_T(0,0,0); DMA_T(1,1,1);
  const bool skew=(wid>=4);
  u32x4 pw0={0u,0u,0u,0u},pw1=pw0,pw2=pw0,pw3=pw0;
  float mhat=0.f,l_reg=0.f; f32x16 o[4]; o[0]=f32x16{};o[1]=f32x16{};o[2]=f32x16{};o[3]=f32x16{}; f32x16 negm=f32x16{};
  const int qrel=wid*QBLK+r32;
  int sl=0,sv=0;
  for(int t=0;t<NT;++t){
    if(t+1<NT){WAIT_BAR(3);}else{WAIT_BAR(0);}
    if(t+2<NT){const int s2=(sl==0)?2:sl-1; DMA_T(t+2,s2,(sv+2)&3);}
    if(skew&&t>0) pv4(o,vb0+((sv+3)&3)*A128_VS,__builtin_bit_cast(bf16x8,pw0),__builtin_bit_cast(bf16x8,pw1),__builtin_bit_cast(bf16x8,pw2),__builtin_bit_cast(bf16x8,pw3));
    f32x16 p0,p1;
    qkt(p0,p1,shm+A128_K+sl*A128_KS,qr,negm,r32,hi);
    { const int jb_=t-(NT-4); if(jb_>=0)cmask(p0,p1,jb_,qrel,hi); }
    const float rm=rowmax_c(p0,p1);
    bool resc=false;
    if(t==0){ const float dl=rm; mhat+=dl;
      #pragma unroll
      for(int r=0;r<16;++r){p0[r]-=dl;p1[r]-=dl;}
      #pragma unroll
      for(int r=0;r<16;++r)negm[r]=-mhat; }
    else if(__any(rm>(float)THRL)){ const float dl=__builtin_fmaxf(rm,0.f); mhat+=dl;
      #pragma unroll
      for(int r=0;r<16;++r){p0[r]-=dl;p1[r]-=dl;}
      #pragma unroll
      for(int r=0;r<16;++r)negm[r]=-mhat;
      const float f=__builtin_amdgcn_exp2f(-dl); l_reg*=f; if(hi==0)wsf[r32]=f; resc=true; }
    if(resc){ asm volatile("s_waitcnt lgkmcnt(0)":::"memory");
      #pragma unroll
      for(int d_=0;d_<4;++d_)
        #pragma unroll
        for(int r=0;r<16;++r)o[d_][r]*=wsf[crow(r,hi)]; }
    float sacc=0.f;
    #pragma unroll
    for(int r=0;r<16;++r){p0[r]=__builtin_amdgcn_exp2f(p0[r]);p1[r]=__builtin_amdgcn_exp2f(p1[r]);sacc+=p0[r]+p1[r];}
    l_reg+=sacc;
    pw0=(u32x4){cvtpk_s(p0[0],p0[1]),cvtpk_s(p0[2],p0[3]),cvtpk_s(p0[4],p0[5]),cvtpk_s(p0[6],p0[7])}; pw1=(u32x4){cvtpk_s(p0[8],p0[9]),cvtpk_s(p0[10],p0[11]),cvtpk_s(p0[12],p0[13]),cvtpk_s(p0[14],p0[15])};
    pw2=(u32x4){cvtpk_s(p1[0],p1[1]),cvtpk_s(p1[2],p1[3]),cvtpk_s(p1[4],p1[5]),cvtpk_s(p1[6],p1[7])}; pw3=(u32x4){cvtpk_s(p1[8],p1[9]),cvtpk_s(p1[10],p1[11]),cvtpk_s(p1[12],p1[13]),cvtpk_s(p1[14],p1[15])};
    if(!skew) pv4(o,vb0+sv*A128_VS,__builtin_bit_cast(bf16x8,pw0),__builtin_bit_cast(bf16x8,pw1),__builtin_bit_cast(bf16x8,pw2),__builtin_bit_cast(bf16x8,pw3));
    sl=(sl==2)?0:sl+1; sv=(sv+1)&3;
  }
  if(skew) pv4(o,vb0+((sv+3)&3)*A128_VS,__builtin_bit_cast(bf16x8,pw0),__builtin_bit_cast(bf16x8,pw1),__builtin_bit_cast(bf16x8,pw2),__builtin_bit_cast(bf16x8,pw3));
  {auto rr=__builtin_amdgcn_permlane32_swap(__float_as_uint(l_reg),__float_as_uint(l_reg),false,false);l_reg=__uint_as_float(rr[0])+__uint_as_float(rr[1]);}
  if(hi==0)wsf[32+r32]=l_reg;asm volatile("s_waitcnt lgkmcnt(0)":::"memory");
  float rli[16];
  #pragma unroll
  for(int r=0;r<16;++r)rli[r]=__builtin_amdgcn_rcpf(wsf[32+crow(r,hi)]);
  bf16*Ow=O+(rowbase+q0+wid*QBLK)*DM+vcol;
  _Float16*stg=(_Float16*)(shm+A128_OST)+wid*2048;
  #pragma unroll
  for(int dh=0;dh<2;++dh){
    #pragma unroll
    for(int r=0;r<16;++r){const int orow=crow(r,hi);
      #pragma unroll
      for(int d0=0;d0<2;++d0)stg[orow*64+d0*32+r32]=(_Float16)(o[dh*2+d0][r]*rli[r]);}
    asm volatile("s_waitcnt lgkmcnt(0)":::"memory");
    #pragma unroll
    for(int i=0;i<4;++i){const int row=i*8+(lane>>3),ch=lane&7; const u32x4 v=*(const u32x4*)(stg+row*64+ch*8); ATTN_STORE16(Ow+(long)row*DM+dh*64+ch*8,v);}
    asm volatile("s_waitcnt lgkmcnt(0)":::"memory");
  }
  asm volatile("s_waitcnt lgkmcnt(0)\n\ts_barrier":::"memory");
  #undef DMA_T
}

constexpr int B128_KS=16384, B128_VS=32768;
constexpr int B128_K=0, B128_V=2*B128_KS, B128_WS=B128_V+2*B128_VS, B128_BYTES=B128_WS+NW*64*4;
static_assert(B128_BYTES<=131072,"attention scratch stays below the LDS control words");
template<int THRL> __device__ __forceinline__ void attn128x2_unit(int b,int qcol,int vcol,int qb,const bf16*Q,const bf16*__restrict__ K,const bf16*__restrict__ V,bf16*O,char*shm){
  const int tid=mk_tid(),lane=tid&63,r32=lane&31,hi=lane>>5; const int wid=__builtin_amdgcn_readfirstlane(tid>>6);
  const long rowbase=(long)b*SEQ; const int q0=qb*QB;
  const bf16*Qw=Q+(rowbase+q0+wid*QBLK)*DM+qcol;
  const bf16*Kh=K+rowbase*DM+qcol,*Vh=V+rowbase*DM+vcol;
  const unsigned lds0=(unsigned)(uintptr_t)shm;
  float*wsf=(float*)(shm+B128_WS)+wid*64;
  const bf16*ksrc=Kh+(long)lane*DM+wid*8;
  const bf16*vsrc=Vh+(long)(16*(wid&3)+(lane>>2))*DM+(wid>>2)*32+(lane&3)*8;
  const unsigned kdst=lds0+B128_K+wid*1024, vdst=lds0+B128_V+wid*1024;
  #define DMA_S(t,sl) do{ _Pragma("unroll") for(int u_=0;u_<2;++u_){ \
      glds16(ksrc+(long)(2*(t)+u_)*KVBLK*DM,(unsigned)__builtin_amdgcn_readfirstlane(kdst+(sl)*B128_KS+u_*8192)); \
      glds16(vsrc+(long)(2*(t)+u_)*KVBLK*DM,(unsigned)__builtin_amdgcn_readfirstlane(vdst+(sl)*B128_VS+u_*16384)); \
      glds16(vsrc+(long)(2*(t)+u_)*KVBLK*DM+64,(unsigned)__builtin_amdgcn_readfirstlane(vdst+(sl)*B128_VS+u_*16384+8192)); } }while(0)
  const lds_cptr vb0=(lds_cptr)shm+B128_V+((lane>>4)&1)*32+(lane&3)*8+(4*hi+((lane&15)>>2))*64;
  const int NS=(q0+QB)/(2*KVBLK);
  bf16x8 qr[4];
  #pragma unroll
  for(int d0=0;d0<4;++d0)qr[d0]=*reinterpret_cast<const bf16x8*>(&Qw[(long)r32*DM+d0*16+hi*8]);
  DMA_S(0,0);
  float mhat=0.f,l_reg=0.f; f32x16 o[4]; o[0]=f32x16{};o[1]=f32x16{};o[2]=f32x16{};o[3]=f32x16{}; f32x16 negm=f32x16{};
  const int qrel=wid*QBLK+r32;
  for(int t=0;t<NS;++t){
    const int sl=t&1;
    WAIT_BAR(0);
    if(t+1<NS) DMA_S(t+1,sl^1);
    f32x16 a0,a1,b0,b1;
    qkt(a0,a1,shm+B128_K+sl*B128_KS,qr,negm,r32,hi);
    qkt(b0,b1,shm+B128_K+sl*B128_KS+8192,qr,negm,r32,hi);
    { const int jb_=2*(t-(NS-2)); if(jb_>=0){ cmask(a0,a1,jb_,qrel,hi); cmask(b0,b1,jb_+1,qrel,hi); } }
    const float rm=__builtin_fmaxf(rowmax_c(a0,a1),rowmax_c(b0,b1));
    bool resc=false;
    if(t==0){ const float dl=rm; mhat+=dl;
      #pragma unroll
      for(int r=0;r<16;++r){a0[r]-=dl;a1[r]-=dl;b0[r]-=dl;b1[r]-=dl;}
      #pragma unroll
      for(int r=0;r<16;++r)negm[r]=-mhat; }
    else if(__any(rm>(float)THRL)){ const float dl=__builtin_fmaxf(rm,0.f); mhat+=dl;
      #pragma unroll
      for(int r=0;r<16;++r){a0[r]-=dl;a1[r]-=dl;b0[r]-=dl;b1[r]-=dl;}
      #pragma unroll
      for(int r=0;r<16;++r)negm[r]=-mhat;
      const float f=__builtin_amdgcn_exp2f(-dl); l_reg*=f; if(hi==0)wsf[r32]=f; resc=true; }
    if(resc){ asm volatile("s_waitcnt lgkmcnt(0)":::"memory");
      #pragma unroll
      for(int d_=0;d_<4;++d_)
        #pragma unroll
        for(int r=0;r<16;++r)o[d_][r]*=wsf[crow(r,hi)]; }
    float sacc=0.f,sacc2=0.f;
    #pragma unroll
    for(int r=0;r<16;++r){a0[r]=__builtin_amdgcn_exp2f(a0[r]);a1[r]=__builtin_amdgcn_exp2f(a1[r]);sacc+=a0[r]+a1[r];}
    #pragma unroll
    for(int r=0;r<16;++r){b0[r]=__builtin_amdgcn_exp2f(b0[r]);b1[r]=__builtin_amdgcn_exp2f(b1[r]);sacc2+=b0[r]+b1[r];}
    l_reg+=sacc+sacc2;
    #define PW4(P,B) (u32x4){cvtpk_s(P[B],P[B+1]),cvtpk_s(P[B+2],P[B+3]),cvtpk_s(P[B+4],P[B+5]),cvtpk_s(P[B+6],P[B+7])}
    { const u32x4 w0=PW4(a0,0),w1=PW4(a0,8),w2=PW4(a1,0),w3=PW4(a1,8);
      pv4(o,vb0+sl*B128_VS,__builtin_bit_cast(bf16x8,w0),__builtin_bit_cast(bf16x8,w1),__builtin_bit_cast(bf16x8,w2),__builtin_bit_cast(bf16x8,w3)); }
    { const u32x4 w0=PW4(b0,0),w1=PW4(b0,8),w2=PW4(b1,0),w3=PW4(b1,8);
      pv4(o,vb0+sl*B128_VS+16384,__builtin_bit_cast(bf16x8,w0),__builtin_bit_cast(bf16x8,w1),__builtin_bit_cast(bf16x8,w2),__builtin_bit_cast(bf16x8,w3)); }
    #undef PW4
  }
  {auto rr=__builtin_amdgcn_permlane32_swap(__float_as_uint(l_reg),__float_as_uint(l_reg),false,false);l_reg=__uint_as_float(rr[0])+__uint_as_float(rr[1]);}
  if(hi==0)wsf[32+r32]=l_reg;asm volatile("s_waitcnt lgkmcnt(0)":::"memory");
  float rli[16];
  #pragma unroll
  for(int r=0;r<16;++r)rli[r]=__builtin_amdgcn_rcpf(wsf[32+crow(r,hi)]);
  bf16*Ow=O+(rowbase+q0+wid*QBLK)*DM+vcol;
  _Float16*stg=(_Float16*)(shm+B128_V+(NS&1)*B128_VS)+wid*2048;
  #pragma unroll
  for(int dh=0;dh<2;++dh){
    #pragma unroll
    for(int r=0;r<16;++r){const int orow=crow(r,hi);
      #pragma unroll
      for(int d0=0;d0<2;++d0)stg[orow*64+d0*32+r32]=(_Float16)(o[dh*2+d0][r]*rli[r]);}
    asm volatile("s_waitcnt lgkmcnt(0)":::"memory");
    #pragma unroll
    for(int i=0;i<4;++i){const int row=i*8+(lane>>3),ch=lane&7; const u32x4 v=*(const u32x4*)(stg+row*64+ch*8); ATTN_STORE16(Ow+(long)row*DM+dh*64+ch*8,v);}
    asm volatile("s_waitcnt lgkmcnt(0)":::"memory");
  }
  asm volatile("s_waitcnt lgkmcnt(0)\n\ts_barrier":::"memory");
  #undef DMA_S
}
#undef SBAR
#undef WAIT_BAR
}
#define LAS __attribute__((address_space(3)))
typedef unsigned short bf16;
typedef unsigned v4u __attribute__((ext_vector_type(4)));
typedef unsigned v2u __attribute__((ext_vector_type(2)));
typedef float f32x4 __attribute__((ext_vector_type(4)));
typedef float f32x16 __attribute__((ext_vector_type(16)));
typedef short bf16x8 __attribute__((ext_vector_type(8)));
typedef short s16x4 __attribute__((ext_vector_type(4)));
typedef _Float16 h16x2 __attribute__((ext_vector_type(2)));

constexpr int NWAVES = 8, NTHR = 512;
constexpr int BATCH = 16, SEQ = 4096, D = 1024, FF = 2816, TOK = BATCH * SEQ;
constexpr int LDS_BYTES = 147456;
constexpr size_t MiB = 1u << 20;
constexpr size_t WS_LB = 0;
constexpr size_t WS_BAR = 65536, BAR_BYTES = 16384;
constexpr int LDS_MISC = 131072;
constexpr size_t WS_RS = 262144;
constexpr size_t WS_CS = 1 * MiB;
constexpr size_t WS_SS = 17 * MiB;
constexpr size_t SS_SLOT = (size_t)TOK * 16;
constexpr size_t WS_W = 25 * MiB;
constexpr size_t WS_XN = 128 * MiB;
constexpr size_t WS_P = 256 * MiB;
constexpr size_t WS_O0 = 768 * MiB, WS_O1 = 896 * MiB;
constexpr size_t WS_END = 1024 * MiB;
constexpr size_t W_AIN = 0, W_AOUT = W_AIN + 2ull * 3072 * 1024, W_HIN = W_AOUT + 2ull * 1024 * 1024, W_HOUT = W_HIN + 2ull * 4096 * 1024,
                 W_FIN = W_HOUT + 2ull * 1024 * 1024, W_FOUT = W_FIN + 4ull * 5632 * 1024, W_ENDE = W_FOUT + 4ull * 1024 * 2816;
static_assert(WS_W + W_ENDE * 2 <= WS_XN, "weights fit");

__device__ const double INVF[32] = {1.0, 0.7498942093324559, 0.5623413251903491, 0.4216965034285822, 0.31622776601683794, 0.23713737056616552, 0.1778279410038923, 0.1333521432163324, 0.1, 0.07498942093324558, 0.05623413251903491, 0.042169650342858224, 0.03162277660168379, 0.023713737056616554, 0.01778279410038923, 0.01333521432163324, 0.01, 0.007498942093324558, 0.005623413251903491, 0.004216965034285823, 0.0031622776601683794, 0.0023713737056616554, 0.0017782794100389228, 0.001333521432163324, 0.001, 0.0007498942093324559, 0.0005623413251903491, 0.00042169650342858224, 0.00031622776601683794, 0.00023713737056616554, 0.00017782794100389227, 0.0001333521432163324};

struct Params { const float* in[18]; float* out; unsigned char* ws; int ph_lo, ph_hi; };

#define LBAR() asm volatile("s_waitcnt lgkmcnt(0)\n\ts_barrier" ::: "memory")
typedef float f32x2_c __attribute__((ext_vector_type(2))); typedef __bf16 bf16x2_c __attribute__((ext_vector_type(2)));
__device__ __forceinline__ unsigned pk2(float lo, float hi) { f32x2_c v = {lo, hi}; bf16x2_c b = __builtin_convertvector(v, bf16x2_c); return __builtin_bit_cast(unsigned, b); }
__device__ __forceinline__ unsigned f2bf(float f) { return pk2(f, 0.f) & 0xffffu; }
__device__ __forceinline__ float bf_lo(unsigned w) { return __builtin_bit_cast(float, w << 16); }
__device__ __forceinline__ float bf_hi(unsigned w) { return __builtin_bit_cast(float, w & 0xffff0000u); }
__device__ __forceinline__ float h_lo(unsigned w) { h16x2 v = __builtin_bit_cast(h16x2, w); return (float)v[0]; }
__device__ __forceinline__ float h_hi(unsigned w) { h16x2 v = __builtin_bit_cast(h16x2, w); return (float)v[1]; }
__device__ __forceinline__ int crow(int r, int hi) { return (r & 3) + 8 * (r >> 2) + 4 * hi; }

#define XB_TMO      128
#define XB_XCNT(j)  (256  + 64 * (j))
#define XB_XSUB(j)  (1280 + 64 * (j))
#define XB_XGEN(j)  (2304 + 64 * (j))
#define XB_TOP      3328
#define XB_TOPGEN   3392
#define XCD_BAR_WORDS 3456
#define XB_SPIN_CAP (1u << 18)

__device__ __forceinline__ unsigned xb_ld(unsigned* p)              { return __hip_atomic_load(p, __ATOMIC_RELAXED, __HIP_MEMORY_SCOPE_AGENT); }
__device__ __forceinline__ unsigned xb_add(unsigned* p, unsigned v) { return __hip_atomic_fetch_add(p, v, __ATOMIC_RELAXED, __HIP_MEMORY_SCOPE_AGENT); }
__device__ __forceinline__ unsigned xb_xcc_id() { return (unsigned)__builtin_amdgcn_s_getreg((3 << 11) | 20) & 0xFu; }
#define XB_SPIN(cond, bar) do { unsigned _sp = 0; while (cond) { __builtin_amdgcn_s_sleep(1); \
    if ((++_sp & 255u) == 0u) { if (xb_ld(&(bar)[XB_TMO])) break; if (_sp > XB_SPIN_CAP) { atomicAdd(&(bar)[XB_TMO], 1u); break; } } } } while (0)

struct XcdBarrier {
    unsigned* bar; unsigned x;
    volatile LAS unsigned* st;
};

__device__ __forceinline__ XcdBarrier xcd_barrier_post(unsigned* bar, volatile LAS unsigned* st) {
    XcdBarrier b; b.bar = bar; b.x = xb_xcc_id(); b.st = st;
    if (threadIdx.x == 0) (void)xb_add(&bar[XB_XCNT(b.x)], 1u);
    return b;
}
__device__ __forceinline__ void xcd_barrier_complete(unsigned* bar, unsigned x, unsigned& nloc, unsigned& nx) {
    const unsigned G = gridDim.x * gridDim.y * gridDim.z;
    unsigned sum, cnt, mine, sp = 0u;
    for (;;) {
        sum = 0u; cnt = 0u; mine = 0u;
#pragma unroll
        for (unsigned j = 0; j < 16; ++j) { const unsigned c = xb_ld(&bar[XB_XCNT(j)]); sum += c; cnt += (c > 0u) ? 1u : 0u; mine = (j == x) ? c : mine; }
        if (sum == G) break;
        __builtin_amdgcn_s_sleep(1);
        if ((++sp & 255u) == 0u) { if (xb_ld(&bar[XB_TMO])) break; if (sp > XB_SPIN_CAP) { atomicAdd(&bar[XB_TMO], 1u); break; } }
    }
    nloc = mine > 0u ? mine : 1u; nx = cnt > 0u ? cnt : 1u;
}

__device__ __forceinline__ void xcd_barrier(const XcdBarrier& b) {
    asm volatile("s_waitcnt vmcnt(0)" ::: "memory");
    __syncthreads();
    if (threadIdx.x == 0) {
        unsigned* bar = b.bar;
        __builtin_amdgcn_s_waitcnt(0);
        unsigned nloc = b.st[0], nx = b.st[1];
        if (nloc == 0u) { xcd_barrier_complete(bar, b.x, nloc, nx); b.st[0] = nloc; b.st[1] = nx; }
        const unsigned old = xb_add(&bar[XB_XSUB(b.x)], 1u);
        const unsigned gen = old / nloc;
        if (old + 1u == (gen + 1u) * nloc) {
            __builtin_amdgcn_fence(__ATOMIC_RELEASE, "agent");
            asm volatile("s_waitcnt vmcnt(0)" ::: "memory");
            const unsigned og = xb_add(&bar[XB_TOP], 1u);
            const unsigned tg = og / nx;
            if (og + 1u == (tg + 1u) * nx) xb_add(&bar[XB_TOPGEN], 1u);
            else XB_SPIN(xb_ld(&bar[XB_TOPGEN]) == tg, bar);
            __builtin_amdgcn_fence(__ATOMIC_ACQUIRE, "agent");
            xb_add(&bar[XB_XGEN(b.x)], 1u);
            asm volatile("s_waitcnt vmcnt(0)" ::: "memory");
        } else {
            XB_SPIN(xb_ld(&bar[XB_XGEN(b.x)]) == gen, bar);
            __builtin_amdgcn_fence(__ATOMIC_ACQUIRE, "agent");
            asm volatile("s_waitcnt vmcnt(0)" ::: "memory");
        }
    }
    __syncthreads();
}

__device__ __forceinline__ int srccol(int mode, int vc) {
    if (mode == 1) { if (vc < 2048) { const int w = vc & 63; return (vc & ~63) + (w >> 1) + 32 * (w & 1); } return vc; }
    if (mode == 2) return (vc & 1) * FF + (vc >> 1);
    return vc;
}
__device__ __forceinline__ void conv_matrix(const float* W, int K, int N, bf16* WT, int mode, const float* nw, LAS float* scr, int gw, int ngw, int lane) {
    const int nblk = N / 32, nitems = (K / 64) * nblk;
    const int c4 = lane & 7, kr = lane >> 3;
    for (int item = gw; item < nitems; item += ngw) {
        const int kb = item / nblk, nb = item % nblk, k0 = 64 * kb, n0 = 32 * nb;
        const bool inter = (mode == 1 && n0 < 2048);
        int sc, vl0, vst;
        if (inter) { const int e = c4 >> 2, i0 = 4 * (c4 & 3);
            sc = (n0 & ~63) + ((n0 & 63) >> 1) + 32 * e + i0;
            vl0 = 2 * i0 + e; vst = 2; }
        else { sc = ((mode == 2) ? ((n0 >> 7) & 1) * FF + 128 * (n0 >> 8) + (n0 & 127) : n0) + 4 * c4; vl0 = 4 * c4; vst = 1; }
#pragma unroll
        for (int i = 0; i < 8; ++i) { const int kk = kr + 8 * i; f32x4 v = *(const f32x4*)(W + (size_t)(k0 + kk) * N + sc); if (nw) v = v * nw[k0 + kk];
            LAS float* d = scr + kk * 33 + vl0; d[0] = v.x; d[vst] = v.y; d[2 * vst] = v.z; d[3 * vst] = v.w; }
        asm volatile("s_waitcnt lgkmcnt(0)" ::: "memory");
        const int c = lane & 7;
#pragma unroll
        for (int j = 0; j < 4; ++j) { const int n = (lane >> 3) + 8 * j; const LAS float* s = scr + (8 * c) * 33 + n;
            v4u o; o.x = pk2(s[0 * 33], s[1 * 33]); o.y = pk2(s[2 * 33], s[3 * 33]); o.z = pk2(s[4 * 33], s[5 * 33]); o.w = pk2(s[6 * 33], s[7 * 33]);
            *(v4u*)(WT + (size_t)(n0 + n) * K + k0 + 8 * c) = o; }
        asm volatile("s_waitcnt lgkmcnt(0)" ::: "memory");
    }
}
__device__ __forceinline__ float wave_sum(float v) {
#pragma unroll
    for (int o = 1; o < 64; o <<= 1) v += __shfl_xor(v, o);
    return v;
}
__device__ __forceinline__ void p0_prologue(const Params& p, LAS unsigned char* lds, int vcu, int G) {
    const int tid = mk_tid(), lane = tid & 63, wave = __builtin_amdgcn_readfirstlane(tid >> 6);
    LAS float* scr = (LAS float*)(lds + wave * 16384);
    const int gw = vcu * NWAVES + wave, ngw = G * NWAVES;
    unsigned char* ws = p.ws;
    bf16* WB = (bf16*)(ws + WS_W);
    for (int j = 0; j < 2; ++j) {
        conv_matrix(p.in[5] + (size_t)j * D * 3 * D, D, 3 * D, WB + W_AIN + (size_t)j * 3 * D * D, 1, p.in[2] + (2 * j) * D, scr, gw, ngw, lane);
        conv_matrix(p.in[6] + (size_t)j * D * D, D, D, WB + W_AOUT + (size_t)j * D * D, 0, nullptr, scr, gw, ngw, lane);
        conv_matrix(p.in[12] + (size_t)j * D * 4 * D, D, 4 * D, WB + W_HIN + (size_t)j * 4 * D * D, 0, p.in[2] + (2 * j + 1) * D, scr, gw, ngw, lane);
        conv_matrix(p.in[13] + (size_t)j * D * D, D, D, WB + W_HOUT + (size_t)j * D * D, 0, nullptr, scr, gw, ngw, lane);
    }
    for (int l = 0; l < 4; ++l) {
        conv_matrix(p.in[16] + (size_t)l * D * 2 * FF, D, 2 * FF, WB + W_FIN + (size_t)l * 2 * FF * D, 2, p.in[3] + l * D, scr, gw, ngw, lane);
        conv_matrix(p.in[17] + (size_t)l * FF * D, FF, D, WB + W_FOUT + (size_t)l * D * FF, 0, nullptr, scr, gw, ngw, lane);
    }
    { const float* x = p.in[0]; bf16* XN = (bf16*)(ws + WS_XN); float* ss0 = (float*)(ws + WS_SS);
      for (int m = gw; m < TOK; m += ngw) {
          const f32x4* xr = (const f32x4*)(x + (size_t)m * D) + lane; f32x4 v[4]; float s = 0.f;
#pragma unroll
          for (int j = 0; j < 4; ++j) { v[j] = xr[64 * j]; s += (v[j].x * v[j].x + v[j].y * v[j].y) + (v[j].z * v[j].z + v[j].w * v[j].w); }
          s = wave_sum(s);
          v2u* o8 = (v2u*)(XN + (size_t)m * D) + lane;
#pragma unroll
          for (int j = 0; j < 4; ++j) { v2u w; w.x = pk2(v[j].x, v[j].y); w.y = pk2(v[j].z, v[j].w); o8[64 * j] = w; }
          if (lane < 16) ss0[(size_t)lane * TOK + m] = (lane == 0) ? s : 0.f;
      } }
    { const int* pos = (const int*)p.in[1]; float* cs = (float*)(ws + WS_CS); const int gt = vcu * NTHR + tid, ngt = G * NTHR;
      for (int idx = gt; idx < TOK * 32; idx += ngt) {
          const int t = idx >> 5, i = idx & 31;
          const double a = (double)pos[t] * INVF[i];
          const double k = __builtin_rint(a * 0.15915494309189535);
          double r = __builtin_fma(-k, 6.283185307179586, a); r = __builtin_fma(-k, 2.4492935982947064e-16, r);
          const float rf = (float)r;
          cs[2 * (size_t)idx] = cosf(rf); cs[2 * (size_t)idx + 1] = sinf(rf);
      } }
    if (vcu == 0) {
        float* LB = (float*)(ws + WS_LB);
        for (int c = tid; c < D; c += NTHR) {
            const float* lp = p.in[15]; const float a0 = lp[c], a1 = lp[D + c], a2 = lp[2 * D + c], a3 = lp[3 * D + c];
            const float mx = fmaxf(fmaxf(a0, a1), fmaxf(a2, a3));
            const float e0 = expf(a0 - mx), e1 = expf(a1 - mx), e2 = expf(a2 - mx), e3 = expf(a3 - mx), inv = 1.0f / (e0 + e1 + e2 + e3);
            LB[c] = e1 * inv; LB[D + c] = (e1 + e2 + e3) * inv;
        }
        if (wave == 0) {
            for (int j = 0; j < 2; ++j) {
                const float s1 = wave_sum(p.in[7][j * 64 + lane] * p.in[8][j * 64 + lane]), s2 = wave_sum(p.in[9][j * 64 + lane] * p.in[10][j * 64 + lane]);
                const float li = (j == 0) ? 0.2f : 0.47071301834358416f;
                if (lane == 0) LB[2 * D + j] = expf(s1) - expf(s2) + li;
            }
        }
    }
}

__device__ __forceinline__ void combine_phase(const unsigned short* O0, const unsigned short* O1, bf16* out, const float* subw, float lam, float post, int vcu, int G) {
    const int tid = mk_tid(), lane = tid & 63, gw = vcu * NWAVES + __builtin_amdgcn_readfirstlane(tid >> 6), ngw = G * NWAVES;
    f32x4 w4[4];
#pragma unroll
    for (int j = 0; j < 4; ++j) w4[j] = *(const f32x4*)(subw + ((16 * lane) & 127) + 4 * j);
    for (int m = gw; m < TOK; m += ngw) {
        const v4u* a = (const v4u*)(O0 + (size_t)m * D + 16 * lane); const v4u* b = (const v4u*)(O1 + (size_t)m * D + 16 * lane);
        const v4u a0 = a[0], a1 = a[1], b0 = b[0], b1 = b[1];
        float d[16];
#pragma unroll
        for (int j = 0; j < 4; ++j) { d[2 * j] = h_lo(a0[j]) - lam * h_lo(b0[j]); d[2 * j + 1] = h_hi(a0[j]) - lam * h_hi(b0[j]);
                                      d[8 + 2 * j] = h_lo(a1[j]) - lam * h_lo(b1[j]); d[9 + 2 * j] = h_hi(a1[j]) - lam * h_hi(b1[j]); }
        float s = 0.f;
#pragma unroll
        for (int j = 0; j < 16; ++j) s += d[j] * d[j];
        s += __shfl_xor(s, 1); s += __shfl_xor(s, 2); s += __shfl_xor(s, 4);
        const float rn = rsqrtf(s * (1.0f / 128.0f) + 1e-5f) * post;
        v4u o0, o1;
#pragma unroll
        for (int j = 0; j < 4; ++j) { o0[j] = pk2(d[2 * j] * rn * w4[j >> 1][2 * (j & 1)], d[2 * j + 1] * rn * w4[j >> 1][2 * (j & 1) + 1]);
                                      o1[j] = pk2(d[8 + 2 * j] * rn * w4[2 + (j >> 1)][2 * (j & 1)], d[9 + 2 * j] * rn * w4[2 + (j >> 1)][2 * (j & 1) + 1]); }
        v4u* op = (v4u*)(out + (size_t)m * D + 16 * lane); op[0] = o0; op[1] = o1;
    }
}
__device__ __forceinline__ void combine_block(const unsigned short* O0, const unsigned short* O1, bf16* out, const float* subw, float lam, float post, size_t row0, int col0) {
    const int tid = mk_tid(), lane = tid & 63, wid = __builtin_amdgcn_readfirstlane(tid >> 6);
    const int seg = lane & 7;
    f32x4 w4[4];
#pragma unroll
    for (int j = 0; j < 4; ++j) w4[j] = *(const f32x4*)(subw + 16 * seg + 4 * j);
#pragma unroll
    for (int step = 0; step < 4; ++step) {
        const size_t m = row0 + wid * 32 + step * 8 + (lane >> 3);
        const v4u* a = (const v4u*)(O0 + m * D + col0 + 16 * seg); const v4u* b = (const v4u*)(O1 + m * D + col0 + 16 * seg);
        const v4u a0 = a[0], a1 = a[1], b0 = b[0], b1 = b[1];
        float d[16];
#pragma unroll
        for (int j = 0; j < 4; ++j) { d[2 * j] = h_lo(a0[j]) - lam * h_lo(b0[j]); d[2 * j + 1] = h_hi(a0[j]) - lam * h_hi(b0[j]);
                                      d[8 + 2 * j] = h_lo(a1[j]) - lam * h_lo(b1[j]); d[9 + 2 * j] = h_hi(a1[j]) - lam * h_hi(b1[j]); }
        float s = 0.f;
#pragma unroll
        for (int j = 0; j < 16; ++j) s += d[j] * d[j];
        s += __shfl_xor(s, 1); s += __shfl_xor(s, 2); s += __shfl_xor(s, 4);
        const float rn = rsqrtf(s * (1.0f / 128.0f) + 1e-5f) * post;
        v4u o0, o1;
#pragma unroll
        for (int j = 0; j < 4; ++j) { o0[j] = pk2(d[2 * j] * rn * w4[j >> 1][2 * (j & 1)], d[2 * j + 1] * rn * w4[j >> 1][2 * (j & 1) + 1]);
                                      o1[j] = pk2(d[8 + 2 * j] * rn * w4[2 + (j >> 1)][2 * (j & 1)], d[9 + 2 * j] * rn * w4[2 + (j >> 1)][2 * (j & 1) + 1]); }
        v4u* op = (v4u*)(out + m * D + col0 + 16 * seg); op[0] = o0; op[1] = o1;
    }
}
__device__ __forceinline__ void gnorm_phase(bf16* O, const bf16* Gt, const float* gw_, int vcu, int G) {
    const int tid = mk_tid(), lane = tid & 63, gw = vcu * NWAVES + __builtin_amdgcn_readfirstlane(tid >> 6), ngw = G * NWAVES;
    f32x4 w4[4];
#pragma unroll
    for (int j = 0; j < 4; ++j) w4[j] = *(const f32x4*)(gw_ + ((16 * lane) & 127) + 4 * j);
    for (int m = gw; m < TOK; m += ngw) {
        v4u* a = (v4u*)(O + (size_t)m * D + 16 * lane); const v4u* b = (const v4u*)(Gt + (size_t)m * D + 16 * lane);
        const v4u a0 = a[0], a1 = a[1], b0 = b[0], b1 = b[1];
        float d[16], g[16];
#pragma unroll
        for (int j = 0; j < 4; ++j) { d[2 * j] = bf_lo(a0[j]); d[2 * j + 1] = bf_hi(a0[j]); d[8 + 2 * j] = bf_lo(a1[j]); d[9 + 2 * j] = bf_hi(a1[j]);
                                      g[2 * j] = bf_lo(b0[j]); g[2 * j + 1] = bf_hi(b0[j]); g[8 + 2 * j] = bf_lo(b1[j]); g[9 + 2 * j] = bf_hi(b1[j]); }
        float s = 0.f;
#pragma unroll
        for (int j = 0; j < 16; ++j) s += d[j] * d[j];
        s += __shfl_xor(s, 1); s += __shfl_xor(s, 2); s += __shfl_xor(s, 4);
        const float rn = rsqrtf(s * (1.0f / 128.0f) + 1e-6f);
        v4u o0, o1;
#pragma unroll
        for (int j = 0; j < 4; ++j) { o0[j] = pk2(d[2 * j] * rn * w4[j >> 1][2 * (j & 1)] * g[2 * j], d[2 * j + 1] * rn * w4[j >> 1][2 * (j & 1) + 1] * g[2 * j + 1]);
                                      o1[j] = pk2(d[8 + 2 * j] * rn * w4[2 + (j >> 1)][2 * (j & 1)] * g[8 + 2 * j], d[9 + 2 * j] * rn * w4[2 + (j >> 1)][2 * (j & 1) + 1] * g[9 + 2 * j]); }
        a[0] = o0; a[1] = o1;
    }
}
__device__ __forceinline__ void final_phase(const bf16* X, float* out, const float* ss, const float* fw, int vcu, int G) {
    const int tid = mk_tid(), lane = tid & 63, gw = vcu * NWAVES + __builtin_amdgcn_readfirstlane(tid >> 6), ngw = G * NWAVES;
    f32x4 w4[4];
#pragma unroll
    for (int j = 0; j < 4; ++j) w4[j] = *(const f32x4*)(fw + 16 * lane + 4 * j);
    for (int m = gw; m < TOK; m += ngw) {
        const float rs = pg8::row_rstd(ss, m, 1e-6f);
        const v4u* a = (const v4u*)(X + (size_t)m * D + 16 * lane); const v4u a0 = a[0], a1 = a[1];
        f32x4* op = (f32x4*)(out + (size_t)m * D + 16 * lane);
        op[0] = (f32x4){bf_lo(a0.x), bf_hi(a0.x), bf_lo(a0.y), bf_hi(a0.y)} * rs * w4[0];
        op[1] = (f32x4){bf_lo(a0.z), bf_hi(a0.z), bf_lo(a0.w), bf_hi(a0.w)} * rs * w4[1];
        op[2] = (f32x4){bf_lo(a1.x), bf_hi(a1.x), bf_lo(a1.y), bf_hi(a1.y)} * rs * w4[2];
        op[3] = (f32x4){bf_lo(a1.z), bf_hi(a1.z), bf_lo(a1.w), bf_hi(a1.w)} * rs * w4[3];
    }
}
constexpr int SC_QDT = 0, SC_KDT = 8192, SC_KET = 16384, SC_VT = 26624, SC_VTB = 5120, SC_DEC = 36864, SC_OP = 37376, SC_END = 53760;
constexpr int KTP = 40;
__device__ __forceinline__ void scan_item(LAS unsigned char* lds, const bf16* Pq, const unsigned short* Plf, const bf16* Pv, bf16* Oo, int item) {
    typedef __attribute__((address_space(3))) const char* lcp;
    const int tid = mk_tid(), lane = tid & 63, wid = __builtin_amdgcn_readfirstlane(tid >> 6);
    const int bh = item >> 1, vs = item & 1, b = bh >> 3, h = bh & 7;
    const size_t row0 = (size_t)b * SEQ;
    LAS unsigned short* QDT = (LAS unsigned short*)(lds + SC_QDT); LAS unsigned short* KDT = (LAS unsigned short*)(lds + SC_KDT);
    LAS unsigned short* KET = (LAS unsigned short*)(lds + SC_KET); LAS unsigned short* VT0 = (LAS unsigned short*)(lds + SC_VT);
    LAS float* DEC = (LAS float*)(lds + SC_DEC); LAS unsigned* OPH = (LAS unsigned*)(lds + SC_OP);
    const int ch = 16 * wid + (lane & 15), tg = lane >> 4;
    const int n32 = lane & 31, hi = lane >> 5, kb = wid >> 1, vb = wid & 1;
    const unsigned short* gq = (const unsigned short*)Pq + (row0 + tg * 8) * D + h * 128 + ch;
    const unsigned short* gl = Plf + (row0 + tg * 8) * D + h * 128 + ch;
    const int vtok = tid & 31, vcg = (tid >> 5) & 7;
    const v4u* gv = (const v4u*)(Pv + (row0 + vtok) * D + h * 128 + vs * 64 + vcg * 8);
    constexpr size_t CSTEP = (size_t)32 * D * 2 / 16, CEL = (size_t)32 * D;
    unsigned rq[8], rl[8]; v4u rv = (v4u){0u, 0u, 0u, 0u};
#pragma unroll
    for (int i = 0; i < 8; ++i) { rq[i] = gq[(size_t)i * D]; rl[i] = gl[(size_t)i * D]; }
    if (tid < 256) rv = gv[0];
    const int troff = ((lane >> 4) & 1) * 32 + (lane & 3) * 8 + (4 * hi + ((lane & 15) >> 2)) * 64;
    f32x16 st;
#pragma unroll
    for (int r = 0; r < 16; ++r) st[r] = 0.f;
    constexpr int NCH = SEQ / 32;
    const int otok = tid & 31, ovq = tid >> 5, ovbb = ovq >> 3, ovl0 = (ovq & 7) * 4;
    bf16* ogp = Oo + (row0 + otok) * D + h * 128 + vs * 64 + ovq * 4;
#define SC_STORE_O(nn) do { float o_[4]; _Pragma("unroll") for (int j = 0; j < 2; ++j) { const int a_ = ovbb * 512 + ((ovl0 >> 1) + j) * 32 + otok; const unsigned w0_ = OPH[a_], w1_ = OPH[a_ + 1024], w2_ = OPH[a_ + 2048], w3_ = OPH[a_ + 3072]; \
        o_[2 * j] = (bf_lo(w0_) + bf_lo(w1_)) + (bf_lo(w2_) + bf_lo(w3_)); o_[2 * j + 1] = (bf_hi(w0_) + bf_hi(w1_)) + (bf_hi(w2_) + bf_hi(w3_)); } \
        v2u w_; w_.x = pk2(o_[0], o_[1]); w_.y = pk2(o_[2], o_[3]); *(v2u*)(ogp + (size_t)(nn) * 32 * D) = w_; } while (0)
#define SC_TRF(base) ({ const s16x4 lo_ = attn_body::vtr((lcp)(base) + troff), hi_ = attn_body::vtr((lcp)(base) + troff + 512); (bf16x8){lo_[0], lo_[1], lo_[2], lo_[3], hi_[0], hi_[1], hi_[2], hi_[3]}; })
    for (int n = 0; n < NCH; ++n) {
        LAS unsigned short* VT = VT0 + (n & 1) * (SC_VTB / 2);
        {
            float f[8]; float tsum = 0.f;
#pragma unroll
            for (int i = 0; i < 8; ++i) { const float l = h_lo(rl[i]); tsum += l; f[i] = __expf(l); }
            const float t0 = __shfl(tsum, lane & 15), t1 = __shfl(tsum, (lane & 15) + 16), t2 = __shfl(tsum, (lane & 15) + 32), t3 = __shfl(tsum, (lane & 15) + 48);
            const float off = (tg > 0 ? t0 : 0.f) + (tg > 1 ? t1 : 0.f) + (tg > 2 ? t2 : 0.f);
            const float blast = (t0 + t1) + (t2 + t3);
            const float eb = __expf(blast);
            float e = __expf(off), qd[8], kd[8], ke[8];
#pragma unroll
            for (int i = 0; i < 8; ++i) {
                e *= f[i];
                const float inv = __builtin_amdgcn_rcpf(e);
                const float k = 1.0f - f[i];
                qd[i] = bf_lo(rq[i]) * e; kd[i] = k * inv; ke[i] = k * (eb * inv);
            }
            v4u w;
            w.x = pk2(qd[0], qd[1]); w.y = pk2(qd[2], qd[3]); w.z = pk2(qd[4], qd[5]); w.w = pk2(qd[6], qd[7]); *(LAS v4u*)(QDT + ch * 32 + tg * 8) = w;
            w.x = pk2(kd[0], kd[1]); w.y = pk2(kd[2], kd[3]); w.z = pk2(kd[4], kd[5]); w.w = pk2(kd[6], kd[7]); *(LAS v4u*)(KDT + ch * 32 + tg * 8) = w;
            w.x = pk2(ke[0], ke[1]); w.y = pk2(ke[2], ke[3]); w.z = pk2(ke[4], ke[5]); w.w = pk2(ke[6], ke[7]); *(LAS v4u*)(KET + ch * KTP + tg * 8) = w;
            if (tg == 0) DEC[ch] = eb;
        }
        if (tid < 256) {
#pragma unroll
            for (int j = 0; j < 4; ++j) { VT[(vcg * 8 + 2 * j) * KTP + vtok] = (unsigned short)(rv[j] & 0xffffu); VT[(vcg * 8 + 2 * j + 1) * KTP + vtok] = (unsigned short)(rv[j] >> 16); }
        }
        if (n + 1 < NCH) {
#pragma unroll
            for (int i = 0; i < 8; ++i) { rq[i] = gq[(size_t)(n + 1) * CEL + (size_t)i * D]; rl[i] = gl[(size_t)(n + 1) * CEL + (size_t)i * D]; }
            if (tid < 256) rv = gv[(size_t)(n + 1) * CSTEP];
        }
        if (n > 0) SC_STORE_O(n - 1);
        LBAR();
        {
            f32x16 sT;
#pragma unroll
            for (int r = 0; r < 16; ++r) sT[r] = 0.f;
#pragma unroll
            for (int s = 0; s < 2; ++s) {
                const bf16x8 a = SC_TRF(KDT + (kb * 2 + s) * 512);
                const bf16x8 bq = SC_TRF(QDT + (kb * 2 + s) * 512);
                sT = __builtin_amdgcn_mfma_f32_32x32x16_bf16(a, bq, sT, 0, 0, 0);
            }
#pragma unroll
            for (int r = 0; r < 16; ++r) { if (crow(r, hi) > n32) sT[r] = 0.f; }
            f32x16 oT;
#pragma unroll
            for (int r = 0; r < 16; ++r) oT[r] = 0.f;
#pragma unroll
            for (int s = 0; s < 2; ++s) {
                v4u bsw; bsw.x = pk2(sT[8 * s + 0], sT[8 * s + 1]); bsw.y = pk2(sT[8 * s + 2], sT[8 * s + 3]); bsw.z = pk2(sT[8 * s + 4], sT[8 * s + 5]); bsw.w = pk2(sT[8 * s + 6], sT[8 * s + 7]);
                const v2u vlo = *(const LAS v2u*)(VT + (vb * 32 + n32) * KTP + 16 * s + 4 * hi), vhi = *(const LAS v2u*)(VT + (vb * 32 + n32) * KTP + 16 * s + 8 + 4 * hi);
                const v4u avw = {vlo.x, vlo.y, vhi.x, vhi.y};
                oT = __builtin_amdgcn_mfma_f32_32x32x16_bf16(__builtin_bit_cast(bf16x8, avw), __builtin_bit_cast(bf16x8, bsw), oT, 0, 0, 0);
                v4u asw; asw.x = pk2(st[8 * s + 0], st[8 * s + 1]); asw.y = pk2(st[8 * s + 2], st[8 * s + 3]); asw.z = pk2(st[8 * s + 4], st[8 * s + 5]); asw.w = pk2(st[8 * s + 6], st[8 * s + 7]);
                const bf16x8 bqp = SC_TRF(QDT + (kb * 2 + s) * 512);
                oT = __builtin_amdgcn_mfma_f32_32x32x16_bf16(__builtin_bit_cast(bf16x8, asw), bqp, oT, 0, 0, 0);
            }
#pragma unroll
            for (int r = 0; r < 16; r += 2) OPH[wid * 512 + (crow(r, hi) >> 1) * 32 + n32] = pk2(oT[r], oT[r + 1]);
#pragma unroll
            for (int r = 0; r < 16; ++r) st[r] *= DEC[kb * 32 + crow(r, hi)];
#pragma unroll
            for (int s = 0; s < 2; ++s) {
                const bf16x8 a = *(const LAS bf16x8*)(KET + (kb * 32 + n32) * KTP + 16 * s + 8 * hi);
                const bf16x8 bv = *(const LAS bf16x8*)(VT + (vb * 32 + n32) * KTP + 16 * s + 8 * hi);
                st = __builtin_amdgcn_mfma_f32_32x32x16_bf16(a, bv, st, 0, 0, 0);
            }
        }
        LBAR();
    }
    SC_STORE_O(NCH - 1);
#undef SC_STORE_O
#undef SC_TRF
    LBAR();
}
constexpr int N_PHASES = 26;
__global__ void __launch_bounds__(NTHR, 2) mk_fwd(Params p) {
    extern __shared__ __attribute__((aligned(16))) unsigned char lds_raw[];
    cg::grid_group grid = cg::this_grid();
    LAS unsigned char* lds = (LAS unsigned char*)lds_raw;
    const int G = gridDim.x, bx = blockIdx.x;
    const int vcu = (G % 8 == 0) ? (bx % 8) * (G / 8) + bx / 8 : bx;
    unsigned char* ws = p.ws;
    bf16* WB = (bf16*)(ws + WS_W); bf16* XN = (bf16*)(ws + WS_XN); bf16* P0 = (bf16*)(ws + WS_P);
    bf16* O0 = (bf16*)(ws + WS_O0); bf16* O1 = (bf16*)(ws + WS_O1);
    float* SS = (float*)(ws + WS_SS); const float* LB = (const float*)(ws + WS_LB); const float* CS = (const float*)(ws + WS_CS);
    const int lo = p.ph_lo, hi = p.ph_hi;
#define IN(k) (lo <= (k) && (k) < hi)
#define SEAM(k) do { if (IN(k) && IN((k) + 1)) { if ((k) == 0) grid.sync(); else xcd_barrier(bar); } } while (0)
    { const int t0 = mk_tid(); if (t0 < 64) ((LAS unsigned*)(lds + LDS_MISC))[t0] = 0u; __syncthreads(); }
    XcdBarrier bar = xcd_barrier_post((unsigned*)(ws + WS_BAR), (volatile LAS unsigned*)(lds + LDS_MISC) + 8);
#ifndef SKIP_P0
    if (IN(0)) p0_prologue(p, lds, vcu, G);
#endif
    SEAM(0);
    LAS unsigned char* RSL = lds + LDS_MISC + 256;
#define RS_PREPASS(S_) do { const int t_ = mk_tid(); pg8::Unit u_; int last_ = -1, ns_ = 0; for (int i_ = 0; (S_).next(i_, u_); ++i_) { if (u_.pm != last_) { last_ = u_.pm; \
        if (t_ < 256) ((LAS float*)(RSL + 256))[ns_ * 256 + t_] = pg8::row_rstd(ss_in, u_.pm * 256 + t_, 1e-6f); if (t_ == 0) RSL[u_.pm] = (unsigned char)ns_; ++ns_; } } \
        asm volatile("s_waitcnt vmcnt(0) lgkmcnt(0)" ::: "memory"); __syncthreads(); } while (0)
#pragma unroll 1
    for (int hl = 0; hl < 8; ++hl) {
        const int L = hl >> 1, pb = 1 + 6 * L, j = L >> 1;
        const float* ss_in = SS + (size_t)(hl & 1) * SS_SLOT; float* ss_out = SS + (size_t)((hl + 1) & 1) * SS_SLOT;
        const bf16* Aop; const bf16* Bop; int Kop, pg4;
        if ((hl & 1) == 0) {
            pg4 = pb + 3; Kop = D;
            if ((L & 1) == 0) {
                Aop = P0; Bop = WB + W_AOUT + (size_t)j * D * D;
#ifndef SKIP_G1
                if (IN(pb)) { pg8::Gemm g{XN, WB + W_AIN + (size_t)j * 3 * D * D, TOK, 3 * D, D}; pg8::StaticOrder S; S.init(TOK, 3 * D, G, bx);
                    RS_PREPASS(S); pg8::EpiQKV E{P0, RSL, CS};
                    pg8::gemm_phase<pg8::EpiQKV, pg8::StaticOrder, true, true>(lds, g, S, E); }
#endif
                SEAM(pb);
#ifndef SKIP_ATTN
                if (IN(pb + 1)) {
                    const attn_body::bf16* Q = (const attn_body::bf16*)P0; const attn_body::bf16* K = (const attn_body::bf16*)(P0 + pg8::TSTRIDE); const attn_body::bf16* V = (const attn_body::bf16*)(P0 + 2 * pg8::TSTRIDE);
#if MK_ATTN128
                    const int ngrp = G >> 3, grp = vcu >> 3, sq = vcu & 7, per = (BATCH * 16) / ngrp;
                    for (int it = 0; it < per; ++it) {
                        const int pu = grp * per + it, b = pu >> 4, uu = pu & 15, h = uu >> 1, c = uu & 1;
                        attn_body::bf16* O = (attn_body::bf16*)(c ? O1 : O0);
                        for (int half = 0; half < 2; ++half) {
                            const int qb = half ? sq : 15 - sq;
#if MK_ATTN_X2
                            attn_body::attn128x2_unit<8>(b, (h * 2 + c) * 64, h * 128, qb, Q, K, V, O, (char*)lds_raw);
#else
                            attn_body::attn128_unit<8>(b, (h * 2 + c) * 64, h * 128, qb, Q, K, V, O, (char*)lds_raw);
#endif
                        }
#if MK_FUSE_COMBINE
                        if (c == 1) {
                            asm volatile("s_waitcnt vmcnt(0)" ::: "memory"); __syncthreads();
                            for (int half = 0; half < 2; ++half)
                                combine_block((const unsigned short*)O0, (const unsigned short*)O1, P0, p.in[11] + j * 128, LB[2 * D + j], (j == 0) ? 0.8f : (1.0f - 0.47071301834358416f), (size_t)b * SEQ + (size_t)(half ? sq : 15 - sq) * 256, h * 128);
                        }
#endif
                    }
                }
#else
                    const int ngrp = G >> 3, grp = vcu >> 3, sq = vcu & 7, per = (BATCH * 32) / ngrp;
                    for (int it = 0; it < per; ++it) {
                        const int pu = grp * per + it, b = pu >> 5, uu = pu & 31, h = uu >> 2, c = (uu >> 1) & 1, vh = uu & 1;
                        attn_body::bf16* O = (attn_body::bf16*)(c ? O1 : O0);
                        for (int half = 0; half < 2; ++half) {
                            const int qb = half ? sq : 15 - sq;
                            attn_body::attn_unit<8>(b, (h * 2 + c) * 64, h * 128 + vh * 64, qb, Q, K, V, O, (char*)lds_raw);
                        }
                    }
                }
#endif
#endif
                SEAM(pb + 1);
#if !(MK_ATTN128 && MK_FUSE_COMBINE)
                if (IN(pb + 2)) combine_phase((const unsigned short*)O0, (const unsigned short*)O1, P0, p.in[11] + j * 128, LB[2 * D + j], (j == 0) ? 0.8f : (1.0f - 0.47071301834358416f), vcu, G);
                SEAM(pb + 2);
#endif
            } else {
                Aop = O0; Bop = WB + W_HOUT + (size_t)j * D * D;
#ifndef SKIP_G2
                if (IN(pb)) { pg8::Gemm g{XN, WB + W_HIN + (size_t)j * 4 * D * D, TOK, 4 * D, D}; pg8::StaticOrder S; S.init(TOK, 4 * D, G, bx);
                    RS_PREPASS(S); pg8::EpiHG E{P0, RSL, LB + j * D};
                    pg8::gemm_phase<pg8::EpiHG, pg8::StaticOrder, true, true>(lds, g, S, E); }
#endif
                SEAM(pb);
#ifndef SKIP_SCAN
                if (IN(pb + 1)) { for (int item = vcu; item < BATCH * 8 * 2; item += G) scan_item(lds, P0, (const unsigned short*)(P0 + pg8::TSTRIDE), P0 + 2 * pg8::TSTRIDE, O0, item); }
#endif
                SEAM(pb + 1);
                if (IN(pb + 2)) gnorm_phase(O0, P0 + 3 * pg8::TSTRIDE, p.in[14] + j * 128, vcu, G);
                SEAM(pb + 2);
            }
        } else {
            pg4 = pb + 5; Kop = FF; Aop = P0; Bop = WB + W_FOUT + (size_t)L * D * FF;
#ifndef SKIP_G3
            if (IN(pb + 4)) { pg8::Gemm g{XN, WB + W_FIN + (size_t)L * 2 * FF * D, TOK, 2 * FF, D}; pg8::StaticOrder S; S.init(TOK, 2 * FF, G, bx);
                RS_PREPASS(S); pg8::EpiFFN E{P0, RSL};
                pg8::gemm_phase<pg8::EpiFFN, pg8::StaticOrder, true, true>(lds, g, S, E); }
#endif
            SEAM(pb + 4);
        }
#ifndef SKIP_G4
        if (IN(pg4)) { pg8::Gemm g{Aop, Bop, TOK, D, Kop}; pg8::StaticOrder S; S.init(TOK, D, G, bx);
            pg8::EpiRes E{XN, ss_out};
            pg8::gemm_phase<pg8::EpiRes, pg8::StaticOrder, true, true>(lds, g, S, E); }
#endif
        SEAM(pg4);
    }
    if (IN(25)) final_phase(XN, p.out, SS, p.in[4], vcu, G);
#undef IN
#undef SEAM
}

extern "C" void kernel_launch(void* const* d_in, const int* in_sizes, int n_in, void* d_out, int out_size, void* d_ws, size_t ws_size, hipStream_t stream) {
    static int grid = 0;
    if (grid == 0) {
        if (n_in != 18 || out_size != TOK * D || ws_size < WS_END) { fprintf(stderr, "kernel_launch: unexpected shapes (n_in %d out %d ws %zu)\n", n_in, out_size, ws_size); grid = -1; return; }
        int dev = 0, cus = 0, per_cu = 0;
        hipGetDevice(&dev); hipDeviceGetAttribute(&cus, hipDeviceAttributeMultiprocessorCount, dev);
        if (hipFuncSetAttribute((const void*)mk_fwd, hipFuncAttributeMaxDynamicSharedMemorySize, LDS_BYTES) != hipSuccess) { fprintf(stderr, "kernel_launch: hipFuncSetAttribute failed\n"); grid = -1; return; }
        if (hipOccupancyMaxActiveBlocksPerMultiprocessor(&per_cu, (const void*)mk_fwd, NTHR, LDS_BYTES) != hipSuccess || per_cu < 1) { fprintf(stderr, "kernel_launch: occupancy query says %d\n", per_cu); per_cu = 1; }
        (void)hipGetLastError();
        grid = cus * 1;
        if (grid > 256) grid = 256;
    }
    if (grid < 0) return;
    (void)hipMemsetAsync((char*)d_ws + WS_BAR, 0, BAR_BYTES, stream);
    Params a{};
    for (int i = 0; i < 18; ++i) a.in[i] = (const float*)d_in[i];
    a.out = (float*)d_out; a.ws = (unsigned char*)d_ws;
#if MK_MULTI
    for (int ph = 0; ph < N_PHASES; ++ph) { a.ph_lo = ph; a.ph_hi = ph + 1; hipLaunchKernelGGL(mk_fwd, dim3(grid), dim3(NTHR), LDS_BYTES, stream, a); }
#else
    a.ph_lo = 0; a.ph_hi = N_PHASES;
    void* args[] = {&a};
    hipError_t e = hipLaunchCooperativeKernel((const void*)mk_fwd, dim3(grid), dim3(NTHR), args, LDS_BYTES, stream);
    if (e != hipSuccess) fprintf(stderr, "cooperative launch failed: %s (grid %d)\n", hipGetErrorString(e), grid);
#endif
}
```
